# Optimizing an MI355X kernel written in HIP

```python
import jax, jax.numpy as jnp
from jax import lax
import numpy as np

D_MODEL = 2048
BATCH = 8
SEQ = 2048
DEPTH = 2

A_HEADS = 16
A_KV_HEADS = 4
A_HEAD_DIM = 64
A_WIDTH = A_HEADS * A_HEAD_DIM
A_KV_WIDTH = A_KV_HEADS * A_HEAD_DIM
WINDOW = 128
BLOCK = 128
ROPE_DIM = A_HEAD_DIM // 4
ROPE_THETA = 500000.0
B_HEADS = 4
B_KEY_DIM = 128
B_VAL_DIM = 256
B_K_WIDTH = B_HEADS * B_KEY_DIM
B_V_WIDTH = B_HEADS * B_VAL_DIM
GATE_RANK = 16
GATE_NORMALIZER = 16.0
CHUNK = 64
D_FF = 5632
CONV_WIDTH = 3
EPS = 1e-6

IN_SIZES = (A_WIDTH, A_KV_WIDTH, A_KV_WIDTH, B_K_WIDTH, B_K_WIDTH, B_V_WIDTH,
            B_V_WIDTH, GATE_RANK, D_MODEL, D_MODEL)
N_IN = sum(IN_SIZES)

kernel_name = "hybrid_swa_sink_gla_convffn"


def rms_norm(x, g):
    xf = x.astype(jnp.float32)
    y = xf * lax.rsqrt(jnp.mean(xf * xf, axis=-1, keepdims=True) + EPS)
    return (y * g.astype(jnp.float32)).astype(x.dtype)


def partial_rope(x, positions):
    half = ROPE_DIM // 2
    inv_freq = ROPE_THETA ** (-jnp.arange(half, dtype=jnp.float32) * 2.0 / ROPE_DIM)
    ang = positions.astype(jnp.float32)[..., None] * inv_freq
    cos = jnp.cos(ang)[:, :, None, :]
    sin = jnp.sin(ang)[:, :, None, :]
    x1 = x[..., :half].astype(jnp.float32)
    x2 = x[..., half:ROPE_DIM].astype(jnp.float32)
    r1 = (x1 * cos - x2 * sin).astype(x.dtype)
    r2 = (x2 * cos + x1 * sin).astype(x.dtype)
    return jnp.concatenate([r1, r2, x[..., ROPE_DIM:]], axis=-1)


def swa_with_sinks(q, k, v, sink):
    Bn, S = q.shape[0], q.shape[1]
    nb = S // BLOCK
    G = A_HEADS // A_KV_HEADS
    qb = q.reshape(Bn, nb, BLOCK, A_KV_HEADS, G, A_HEAD_DIM)

    def band(t):
        tb = t.reshape(Bn, nb, BLOCK, A_KV_HEADS, A_HEAD_DIM)
        prev = jnp.pad(tb, ((0, 0), (1, 0), (0, 0), (0, 0), (0, 0)))[:, :-1]
        return jnp.concatenate([prev, tb], axis=2)

    kb, vb = band(k), band(v)
    s = jnp.einsum('bnqhgd,bnkhd->bnhgqk', qb, kb,
                   preferred_element_type=jnp.float32) * (A_HEAD_DIM ** -0.5)
    qi = jnp.arange(BLOCK)[:, None]
    ki = jnp.arange(2 * BLOCK)[None, :]
    rel = qi + BLOCK - ki
    in_win = (rel >= 0) & (rel < WINDOW)
    blk = jnp.arange(nb)[:, None, None]
    valid = in_win[None] & ((blk > 0) | (ki[None] >= BLOCK))
    s = jnp.where(valid[None, :, None, None], s, -jnp.inf)
    sink_l = sink.astype(jnp.float32).reshape(A_KV_HEADS, G)[None, None, :, :, None, None]
    m = jnp.maximum(jnp.max(s, axis=-1, keepdims=True), sink_l)
    p = jnp.exp(s - m)
    p = p / (jnp.sum(p, axis=-1, keepdims=True) + jnp.exp(sink_l - m))
    o = jnp.einsum('bnhgqk,bnkhd->bnqhgd', p.astype(v.dtype), vb)
    return o.reshape(Bn, S, A_WIDTH)


def gla_chunked(q, k, v, log_a):
    Bn, S, H, dk = q.shape
    dv = v.shape[-1]
    nc = S // CHUNK
    f32 = jnp.float32

    def chunk(t):
        return t.astype(f32).reshape(Bn, nc, CHUNK, H, t.shape[-1])

    qc = chunk(q) * (dk ** -0.5)
    kc = chunk(k)
    vc = chunk(v)
    b = jnp.cumsum(chunk(log_a), axis=2)
    b_last = b[:, :, -1:]
    q_dec = qc * jnp.exp(b)
    k_inv = kc * jnp.exp(-b)
    k_end = kc * jnp.exp(b_last - b)
    causal = jnp.tril(jnp.ones((CHUNK, CHUNK), dtype=bool))
    attn = jnp.einsum('bclhd,bcshd->bchls', q_dec, k_inv)
    attn = jnp.where(causal, attn, 0.0)
    o_intra = jnp.einsum('bchls,bcshe->bclhe', attn, vc)
    dstate = jnp.einsum('bcshd,bcshe->bchde', k_end, vc)
    decay = jnp.exp(b_last[:, :, 0])

    def step(state, inp):
        dec, ds = inp
        return dec[..., None] * state + ds, state

    s0 = jnp.zeros((Bn, H, dk, dv), f32)
    _, s_prev = lax.scan(step, s0, (jnp.moveaxis(decay, 1, 0), jnp.moveaxis(dstate, 1, 0)))
    o_inter = jnp.einsum('bclhd,cbhde->bclhe', q_dec, s_prev)
    return (o_intra + o_inter).reshape(Bn, S, H, dv).astype(v.dtype)


def causal_depthwise_conv(h, w, b):
    S = h.shape[1]
    hp = jnp.pad(h, ((0, 0), (CONV_WIDTH - 1, 0), (0, 0)))
    out = b
    for j in range(CONV_WIDTH):
        out = out + w[j] * hp[:, j:j + S]
    return out


def setup_inputs(seed: int = 0) -> dict:
    key = jax.random.key(seed)
    ks = jax.random.split(key, 20)
    f32 = jnp.float32
    nrm = lambda k, shape, scale: jax.random.normal(k, shape, f32) * scale
    x = jax.random.normal(ks[0], (BATCH, SEQ, D_MODEL), f32)
    start = jax.random.randint(ks[1], (BATCH, 1), 0, 4096, dtype=jnp.int32)
    positions = (start + jnp.arange(SEQ, dtype=jnp.int32)[None, :]).astype(jnp.int32)
    return {
        "x": x,
        "positions": positions,
        "norm_mix_g": 1.0 + nrm(ks[2], (DEPTH, D_MODEL), 0.02),
        "w_in": nrm(ks[3], (DEPTH, D_MODEL, N_IN), D_MODEL ** -0.5),
        "sink": nrm(ks[4], (DEPTH, A_HEADS), 0.5),
        "w_alpha_up": nrm(ks[5], (DEPTH, GATE_RANK, B_K_WIDTH), GATE_RANK ** -0.5),
        "b_alpha": nrm(ks[6], (DEPTH, B_K_WIDTH), 0.01),
        "gla_norm_g": 1.0 + nrm(ks[7], (DEPTH, B_VAL_DIM), 0.02),
        "w_branch_a": nrm(ks[8], (DEPTH, A_WIDTH, D_MODEL), A_WIDTH ** -0.5),
        "w_branch_b": nrm(ks[9], (DEPTH, B_V_WIDTH, D_MODEL), B_V_WIDTH ** -0.5),
        "w_out": nrm(ks[10], (DEPTH, D_MODEL, D_MODEL), D_MODEL ** -0.5),
        "norm_ffn_g": 1.0 + nrm(ks[11], (DEPTH, D_MODEL), 0.02),
        "w_up": nrm(ks[12], (DEPTH, D_MODEL, 2 * D_FF), D_MODEL ** -0.5),
        "conv_w": nrm(ks[13], (DEPTH, CONV_WIDTH, 2 * D_FF), CONV_WIDTH ** -0.5),
        "conv_b": nrm(ks[14], (DEPTH, 2 * D_FF), 0.01),
        "w_down": nrm(ks[15], (DEPTH, D_FF, D_MODEL), D_FF ** -0.5),
        "final_g": 1.0 + nrm(ks[16], (D_MODEL,), 0.02),
    }


def reference(x, positions, norm_mix_g, w_in, sink, w_alpha_up, b_alpha, gla_norm_g,
              w_branch_a, w_branch_b, w_out, norm_ffn_g, w_up, conv_w, conv_b, w_down,
              final_g):
    Bn, S = x.shape[0], x.shape[1]
    offsets = np.cumsum(IN_SIZES)[:-1].tolist()
    for l in range(DEPTH):
        xn = rms_norm(x, norm_mix_g[l])
        z = xn @ w_in[l]
        qa, ka, va, qb, kb, vb, rb, alpha_lr, gate_a, gate_b = jnp.split(z, offsets, axis=-1)
        qa = partial_rope(qa.reshape(Bn, S, A_HEADS, A_HEAD_DIM), positions)
        ka = partial_rope(ka.reshape(Bn, S, A_KV_HEADS, A_HEAD_DIM), positions)
        va = va.reshape(Bn, S, A_KV_HEADS, A_HEAD_DIM)
        ya = swa_with_sinks(qa, ka, va, sink[l])
        log_a = jax.nn.log_sigmoid((alpha_lr @ w_alpha_up[l] + b_alpha[l]).astype(jnp.float32)) / GATE_NORMALIZER
        ob = gla_chunked(qb.reshape(Bn, S, B_HEADS, B_KEY_DIM),
                         kb.reshape(Bn, S, B_HEADS, B_KEY_DIM),
                         vb.reshape(Bn, S, B_HEADS, B_VAL_DIM),
                         log_a.reshape(Bn, S, B_HEADS, B_KEY_DIM))
        ob = rms_norm(ob, gla_norm_g[l]) * jax.nn.silu(rb.reshape(Bn, S, B_HEADS, B_VAL_DIM))
        yb = ob.reshape(Bn, S, B_V_WIDTH)
        mixed = (jax.nn.sigmoid(gate_a) * (ya @ w_branch_a[l])
                 + jax.nn.sigmoid(gate_b) * (yb @ w_branch_b[l]))
        x = x + mixed @ w_out[l]
        h = rms_norm(x, norm_ffn_g[l]) @ w_up[l]
        h = causal_depthwise_conv(h, conv_w[l], conv_b[l])
        g, u = jnp.split(h, 2, axis=-1)
        x = x + (jax.nn.silu(g) * u) @ w_down[l]
    return rms_norm(x, final_g)
```

```cpp
#include <hip/hip_runtime.h>
#include <cstdio>
#include <cstdint>
#include <cmath>
namespace pg8 {
#define PG8_LAS __attribute__((address_space(3)))
typedef unsigned short bf16_t;
typedef short bf16x8 __attribute__((ext_vector_type(8)));
typedef float f32x4 __attribute__((ext_vector_type(4)));
typedef unsigned u32x4 __attribute__((ext_vector_type(4)));
constexpr int BM = 256, BK = 64, HALF = 128, HTB = HALF * BK * 2  , STAGE_BYTES = 8 * HTB, NXCD = 8, WGM = 8;

__host__ __device__ __forceinline__ int lds_byte(int r, int c) { const int st = (r >> 4) * 2 + (c >> 5), rr = r & 15, cc = c & 31, ob = rr * 64 + cc * 2; return st * 1024 + (ob ^ (((ob >> 9) & 1) << 5)); }
__host__ __device__ __forceinline__ void stage_rc(int b, int& R, int& C) { const int st = b / 1024, sb = b % 1024, swz = sb ^ (((sb >> 9) & 1) << 5); R = (st >> 1) * 16 + swz / 64; C = (st & 1) * 32 + (swz % 64) / 2; }
__host__ __device__ __forceinline__ int perm32(int rho) { const int n = rho >> 4, i = rho & 15; return 8 * (i >> 2) + 4 * n + (i & 3); }

struct Unit { int pm, pn; };
struct Gemm { const bf16_t* A; const bf16_t* Bt; int M, N, K, lda; };

struct StaticOrder {
    int nM, nN, nwg, G, c;
    __host__ __device__ void init(int M, int N, int G_, int c_) { nM = M / BM; nN = N / BM; nwg = nM * nN; G = G_; c = c_; }
    __host__ __device__ bool next(int i, Unit& u) const {
        const long L = (long)i * G + c; if (L >= nwg) return false;
        int wgid = (int)L; { const int q = nwg / NXCD, r = nwg % NXCD, xcd = wgid % NXCD, off = wgid / NXCD; wgid = (xcd < r ? xcd * (q + 1) : r * (q + 1) + (xcd - r) * q) + off; }
        const int nig = WGM * nN, gid = wgid / nig, fm = gid * WGM, gsz = (nM - fm) < WGM ? (nM - fm) : WGM;
        u.pm = fm + ((wgid % nig) % gsz); u.pn = (wgid % nig) / gsz; return true;
    }
    __device__ __forceinline__ void a_ready(const Unit&) const {}
    __device__ __forceinline__ void done(const Unit&) const {}
};

__device__ __forceinline__ unsigned cvt_pk_bf16(float lo, float hi) { unsigned r; asm volatile("v_cvt_pk_bf16_f32 %0, %1, %2" : "=v"(r) : "v"(lo), "v"(hi)); return r; }
__device__ __forceinline__ u32x4 pack8(f32x4 a, f32x4 b) { u32x4 w; w.x = cvt_pk_bf16(a[0], a[1]); w.y = cvt_pk_bf16(a[2], a[3]); w.z = cvt_pk_bf16(b[0], b[1]); w.w = cvt_pk_bf16(b[2], b[3]); return w; }
__device__ __forceinline__ f32x4 unlo(u32x4 w) { return (f32x4){__uint_as_float(w.x << 16), __uint_as_float(w.x & 0xffff0000u), __uint_as_float(w.y << 16), __uint_as_float(w.y & 0xffff0000u)}; }
__device__ __forceinline__ f32x4 unhi(u32x4 w) { return (f32x4){__uint_as_float(w.z << 16), __uint_as_float(w.z & 0xffff0000u), __uint_as_float(w.w << 16), __uint_as_float(w.w & 0xffff0000u)}; }

constexpr int NZ = 9216;
constexpr int ZQA = 0, ZKA = 1024, ZVA = 1280, ZQB = 1536, ZKB = 2048, ZVB = 2560, ZRB = 3584, ZAL = 4608, ZGA = 5120, ZGB = 7168;
constexpr float LOG2E = 1.4426950408889634f;
constexpr float QA_SCALE = 0.125f * LOG2E;
constexpr float QB_SCALE = 0.08838834764831845f;
constexpr float RMS_EPS = 1e-6f;

__device__ __forceinline__ float row_rstd(const float* ssq, int row, int fq) {
    const f32x4* p = (const f32x4*)(ssq + (size_t)row * 32 + fq * 8);
    const f32x4 a = p[0], b = p[1];
    float s = ((a[0] + a[1]) + (a[2] + a[3])) + ((b[0] + b[1]) + (b[2] + b[3]));
    s += __shfl_xor(s, 16); s += __shfl_xor(s, 32);
    return 1.0f / sqrtf(s * (1.0f / 2048.0f) + RMS_EPS);
}
__device__ __forceinline__ float sigmoidf_fast(float x) { return __builtin_amdgcn_rcpf(1.0f + __expf(-x)); }

struct EpiZ {
    static constexpr bool PERM = true, AFTER_DRAIN = false;
    bf16_t* Z; float* LA; const float* ssq; const float* cs; const float* balpha;
    __device__ __forceinline__ void operator()(const f32x4 (&acc)[2][2][4][2], const Unit& u, int wr, int wc, int fr, int fq) const {
        const int pn = u.pn, row0 = u.pm * BM + wr * 64 + fr, colw = wc * 32 + 8 * fq;
#pragma unroll
        for (int ai = 0; ai < 2; ++ai)
#pragma unroll
            for (int m = 0; m < 4; ++m) {
                const int row = row0 + ai * HALF + m * 16;
                const float rs = row_rstd(ssq, row, fq);
                f32x4 v[2][2];
#pragma unroll
                for (int bj = 0; bj < 2; ++bj)
#pragma unroll
                    for (int n = 0; n < 2; ++n) v[bj][n] = acc[ai][bj][m][n] * rs;
                if (pn < 5) {
                    if ((wc & 1) == 0) {
                        const f32x4* cp = (const f32x4*)(cs + (size_t)row * 16);
                        const f32x4 c0 = cp[0], c1 = cp[1], c2 = cp[2], c3 = cp[3];
                        const float cc[8] = {c0[0], c0[2], c1[0], c1[2], c2[0], c2[2], c3[0], c3[2]};
                        const float sn[8] = {c0[1], c0[3], c1[1], c1[3], c2[1], c2[3], c3[1], c3[3]};
#pragma unroll
                        for (int bj = 0; bj < 2; ++bj)
#pragma unroll
                            for (int n = 0; n < 2; ++n)
#pragma unroll
                                for (int i = 0; i < 4; ++i) {
                                    const float own = v[bj][n][i], oth = __shfl_xor(own, 16);
                                    const float r1 = own * cc[4 * n + i] - oth * sn[4 * n + i];
                                    const float r2 = own * cc[4 * n + i] + oth * sn[4 * n + i];
                                    v[bj][n][i] = fq == 0 ? r1 : (fq == 1 ? r2 : own);
                                }
                    }
                    if (pn < 4) {
#pragma unroll
                        for (int bj = 0; bj < 2; ++bj)
#pragma unroll
                            for (int n = 0; n < 2; ++n) v[bj][n] = v[bj][n] * QA_SCALE;
                    }
                } else if (pn < 14) {
                    if (pn == 6 || pn == 7) {
#pragma unroll
                        for (int bj = 0; bj < 2; ++bj)
#pragma unroll
                            for (int n = 0; n < 2; ++n) v[bj][n] = v[bj][n] * QB_SCALE;
                    }
                } else if (pn < 18) {
#pragma unroll
                    for (int bj = 0; bj < 2; ++bj)
#pragma unroll
                        for (int n = 0; n < 2; ++n)
#pragma unroll
                            for (int i = 0; i < 4; ++i) { const float x = v[bj][n][i]; v[bj][n][i] = x * sigmoidf_fast(x); }
                } else if (pn < 20) {
#pragma unroll
                    for (int bj = 0; bj < 2; ++bj)
#pragma unroll
                        for (int n = 0; n < 2; ++n) {
                            const int j = (pn - 18) * 256 + bj * HALF + colw + 4 * n;
                            const f32x4 bb = *(const f32x4*)(balpha + j);
                            f32x4 o;
#pragma unroll
                            for (int i = 0; i < 4; ++i) { const float x = v[bj][n][i] + bb[i]; const float ls = fminf(x, 0.0f) - log1pf(__expf(-fabsf(x))); o[i] = ls * (LOG2E / 16.0f); }
                            *(f32x4*)(LA + (size_t)row * 512 + j) = o;
                        }
                    continue;
                } else {
#pragma unroll
                    for (int bj = 0; bj < 2; ++bj)
#pragma unroll
                        for (int n = 0; n < 2; ++n)
#pragma unroll
                            for (int i = 0; i < 4; ++i) v[bj][n][i] = sigmoidf_fast(v[bj][n][i]);
                }
                bf16_t* rowp = Z + (size_t)row * NZ + pn * BM + colw;
#pragma unroll
                for (int bj = 0; bj < 2; ++bj) *(u32x4*)(rowp + bj * HALF) = pack8(v[bj][0], v[bj][1]);
            }
    }
};
template <bool ADD> struct EpiGate {
    static constexpr bool PERM = true, AFTER_DRAIN = false;
    bf16_t* O; const bf16_t* G;
    __device__ __forceinline__ void operator()(const f32x4 (&acc)[2][2][4][2], const Unit& u, int wr, int wc, int fr, int fq) const {
        const int row0 = u.pm * BM + wr * 64 + fr, col0 = u.pn * BM + wc * 32 + 8 * fq;
#pragma unroll
        for (int ai = 0; ai < 2; ++ai)
#pragma unroll
            for (int m = 0; m < 4; ++m) {
                const int row = row0 + ai * HALF + m * 16;
#pragma unroll
                for (int bj = 0; bj < 2; ++bj) {
                    const int col = col0 + bj * HALF;
                    const u32x4 gw = *(const u32x4*)(G + (size_t)row * NZ + col);
                    f32x4 v0 = acc[ai][bj][m][0] * unlo(gw), v1 = acc[ai][bj][m][1] * unhi(gw);
                    bf16_t* op = O + (size_t)row * 2048 + col;
                    if (ADD) { const u32x4 tw = *(const u32x4*)op; v0 = v0 + unlo(tw); v1 = v1 + unhi(tw); }
                    *(u32x4*)op = pack8(v0, v1);
                }
            }
    }
};
struct EpiRes {
    static constexpr bool PERM = true, AFTER_DRAIN = false;
    const float* res; float* out; bf16_t* xb; float* ssq;
    __device__ __forceinline__ void operator()(const f32x4 (&acc)[2][2][4][2], const Unit& u, int wr, int wc, int fr, int fq) const {
        const int row0 = u.pm * BM + wr * 64 + fr, col0 = u.pn * BM + wc * 32 + 8 * fq;
#pragma unroll
        for (int ai = 0; ai < 2; ++ai)
#pragma unroll
            for (int m = 0; m < 4; ++m) {
                const int row = row0 + ai * HALF + m * 16;
                float sq = 0.0f;
#pragma unroll
                for (int bj = 0; bj < 2; ++bj) {
                    const size_t off = (size_t)row * 2048 + col0 + bj * HALF;
                    const f32x4 r0 = *(const f32x4*)(res + off), r1 = *(const f32x4*)(res + off + 4);
                    const f32x4 x0 = r0 + acc[ai][bj][m][0], x1 = r1 + acc[ai][bj][m][1];
                    *(f32x4*)(out + off) = x0; *(f32x4*)(out + off + 4) = x1;
                    sq += ((x0[0] * x0[0] + x0[1] * x0[1]) + (x0[2] * x0[2] + x0[3] * x0[3])) + ((x1[0] * x1[0] + x1[1] * x1[1]) + (x1[2] * x1[2] + x1[3] * x1[3]));
                    *(u32x4*)(xb + off) = pack8(x0, x1);
                }
                sq += __shfl_xor(sq, 16); sq += __shfl_xor(sq, 32);
                if (fq == 0) ssq[(size_t)row * 32 + u.pn * 4 + wc] = sq;
            }
    }
};
struct EpiH {
    static constexpr bool PERM = true, AFTER_DRAIN = false;
    bf16_t* O; int ldc; const float* ssq;
    __device__ __forceinline__ void operator()(const f32x4 (&acc)[2][2][4][2], const Unit& u, int wr, int wc, int fr, int fq) const {
        const int row0 = u.pm * BM + wr * 64 + fr, col0 = u.pn * BM + wc * 32 + 8 * fq;
#pragma unroll
        for (int ai = 0; ai < 2; ++ai)
#pragma unroll
            for (int m = 0; m < 4; ++m) {
                const int row = row0 + ai * HALF + m * 16;
                const float rs = row_rstd(ssq, row, fq);
#pragma unroll
                for (int bj = 0; bj < 2; ++bj) *(u32x4*)(O + (size_t)row * ldc + col0 + bj * HALF) = pack8(acc[ai][bj][m][0] * rs, acc[ai][bj][m][1] * rs);
            }
    }
};
template <class Epi, class Sched, bool ALIGN_EPI = false, bool SP2 = false>
__device__ __forceinline__ void gemm_phase(PG8_LAS unsigned char* lds, const Gemm g, const Sched& S, const Epi& E, const int tid) {
    const int wid = __builtin_amdgcn_readfirstlane(tid >> 6), lane = tid & 63, wr = wid >> 2, wc = wid & 3, fr = lane & 15, fq = lane >> 4;
    const int K = g.K, nt = K / BK, lda = g.lda;
    unsigned voffA[2], voffB[2];
#pragma unroll
    for (int i = 0; i < 2; ++i) { int R, C; stage_rc(tid * 16 + i * 8192, R, C); const int Rb = Epi::PERM ? ((R & ~31) + perm32(R & 31)) : R;
        voffA[i] = (unsigned)(R * lda + C) * 2u; voffB[i] = (unsigned)(Rb * K + C) * 2u; }
    const size_t kstep = (size_t)(BK * 2);
    const size_t hA = (size_t)HALF * lda * 2, hB = (size_t)HALF * K * 2;
    const size_t tA = 2 * hA, tB = 2 * hB;
    const unsigned ldsw = (unsigned)wid * 1024u;
    const int aoff = lds_byte(wr * 64 + fr, fq * 8), boff = lds_byte(wc * 32 + fr, fq * 8);
#define PG8_SA(b, h) (((b) * 2 + (h)) * HTB)
#define PG8_SB(b, h) ((4 + (b) * 2 + (h)) * HTB)
#define PG8_STAGE(bufoff, gbase, voff) do { _Pragma("unroll") for (int _i = 0; _i < 2; ++_i) \
        __builtin_amdgcn_global_load_lds((const unsigned*)((const char*)(gbase) + (voff)[_i]), (PG8_LAS unsigned*)(lds + (bufoff) + ldsw + _i * 8192), 16, 0, 0); } while (0)
#define PG8_LDA(dst, b, h) do { _Pragma("unroll") for (int m = 0; m < 4; ++m) _Pragma("unroll") for (int k = 0; k < 2; ++k) dst[m][k] = *(const PG8_LAS bf16x8*)(lds + PG8_SA(b, h) + aoff + m * 2048 + k * 1024); } while (0)
#define PG8_LDB(dst, b, h) do { _Pragma("unroll") for (int n = 0; n < 2; ++n) _Pragma("unroll") for (int k = 0; k < 2; ++k) dst[n][k] = *(const PG8_LAS bf16x8*)(lds + PG8_SB(b, h) + boff + n * 2048 + k * 1024); } while (0)
#define PG8_MMA(ai, bj, At, Bt) do { __builtin_amdgcn_s_setprio(1); _Pragma("unroll") for (int m = 0; m < 4; ++m) _Pragma("unroll") for (int n = 0; n < 2; ++n) _Pragma("unroll") for (int k = 0; k < 2; ++k) \
        acc[ai][bj][m][n] = __builtin_amdgcn_mfma_f32_16x16x32_bf16(Bt[n][k], At[m][k], acc[ai][bj][m][n], 0, 0, 0); __builtin_amdgcn_s_setprio(0); } while (0)
#define PG8_WAIT_V(n) asm volatile("s_waitcnt vmcnt(" #n ")" ::: "memory")
#define PG8_WAIT_L(n) asm volatile("s_waitcnt lgkmcnt(" #n ")" ::: "memory")
#define PG8_BAR __builtin_amdgcn_s_barrier()
#define PG8_SCHED __builtin_amdgcn_sched_barrier(0)
    Unit cur, nxt; int ui = 0;
    if (!S.next(0, cur)) return;
    f32x4 acc[2][2][4][2];
#pragma unroll
    for (int a = 0; a < 2; ++a)
#pragma unroll
        for (int b = 0; b < 2; ++b)
#pragma unroll
            for (int m = 0; m < 4; ++m)
#pragma unroll
                for (int n = 0; n < 2; ++n) acc[a][b][m][n] = (f32x4){0.f, 0.f, 0.f, 0.f};
    bf16x8 At[4][2], B0[2][2], B1[2][2];
    const char* cA = (const char*)g.A + (size_t)cur.pm * tA; const char* cB = (const char*)g.Bt + (size_t)cur.pn * tB;
    S.a_ready(cur);
    if constexpr (SP2) {
        PG8_STAGE(PG8_SB(0, 0), cB, voffB); PG8_STAGE(PG8_SB(0, 1), cB + hB, voffB); PG8_STAGE(PG8_SA(0, 0), cA, voffA); PG8_STAGE(PG8_SA(0, 1), cA + hA, voffA);
        if (wr == 1) PG8_BAR;
        PG8_WAIT_V(2); PG8_BAR;
        PG8_STAGE(PG8_SB(1, 0), cB + kstep, voffB); PG8_STAGE(PG8_SA(1, 0), cA + kstep, voffA); PG8_STAGE(PG8_SB(1, 1), cB + hB + kstep, voffB);
        PG8_WAIT_V(6); PG8_BAR;
    } else {
        PG8_STAGE(PG8_SB(0, 0), cB, voffB); PG8_STAGE(PG8_SA(0, 0), cA, voffA); PG8_STAGE(PG8_SB(0, 1), cB + hB, voffB); PG8_STAGE(PG8_SA(0, 1), cA + hA, voffA);
        if (wr == 1) PG8_BAR;
        PG8_WAIT_V(4); PG8_BAR;
        PG8_STAGE(PG8_SB(1, 0), cB + kstep, voffB); PG8_STAGE(PG8_SA(1, 0), cA + kstep, voffA); PG8_STAGE(PG8_SB(1, 1), cB + hB + kstep, voffB);
        PG8_WAIT_V(6); PG8_BAR;
    }
    for (;;) {
        const bool has_next = S.next(ui + 1, nxt);
        const char* nA = has_next ? (const char*)g.A + (size_t)nxt.pm * tA : cA; const char* nB = has_next ? (const char*)g.Bt + (size_t)nxt.pn * tB : cB;
        for (int t = 0; t < nt; t += 2) {
            const bool last = (t == nt - 2);
            const char* a1 = cA + (size_t)(t + 1) * kstep;
            const char* a2 = last ? nA : cA + (size_t)(t + 2) * kstep; const char* b2 = last ? nB : cB + (size_t)(t + 2) * kstep;
            const char* a3 = a2 + kstep; const char* b3 = b2 + kstep;
            if (last && has_next) S.a_ready(nxt);
            if constexpr (SP2) {
            PG8_LDB(B0, 0, 0); PG8_LDB(B1, 0, 1); PG8_SCHED; PG8_LDA(At, 0, 0); PG8_STAGE(PG8_SA(1, 1), a1 + hA, voffA);
            PG8_WAIT_V(8); PG8_WAIT_L(0); PG8_BAR; PG8_MMA(0, 0, At, B0); PG8_MMA(0, 1, At, B1); PG8_BAR; PG8_SCHED;
            PG8_LDA(At, 0, 1); PG8_STAGE(PG8_SB(0, 0), b2, voffB); PG8_STAGE(PG8_SB(0, 1), b2 + hB, voffB); PG8_STAGE(PG8_SA(0, 0), a2, voffA);
            PG8_WAIT_V(8); PG8_WAIT_L(0); PG8_BAR; PG8_MMA(1, 0, At, B0); PG8_MMA(1, 1, At, B1); PG8_BAR; PG8_SCHED;
            PG8_LDB(B0, 1, 0); PG8_LDB(B1, 1, 1); PG8_SCHED; PG8_LDA(At, 1, 0); PG8_STAGE(PG8_SA(0, 1), a2 + hA, voffA);
            PG8_WAIT_V(8); PG8_WAIT_L(0); PG8_BAR; PG8_MMA(0, 0, At, B0); PG8_MMA(0, 1, At, B1); PG8_BAR; PG8_SCHED;
            PG8_LDA(At, 1, 1); PG8_STAGE(PG8_SB(1, 0), b3, voffB); PG8_STAGE(PG8_SB(1, 1), b3 + hB, voffB); PG8_STAGE(PG8_SA(1, 0), a3, voffA);
            PG8_WAIT_V(8); PG8_WAIT_L(0); PG8_BAR; PG8_MMA(1, 0, At, B0); PG8_MMA(1, 1, At, B1); PG8_BAR; PG8_SCHED;
            } else {
            PG8_LDB(B0, 0, 0); PG8_SCHED; PG8_LDA(At, 0, 0); PG8_STAGE(PG8_SA(1, 1), a1 + hA, voffA);
            PG8_WAIT_L(8); PG8_BAR; PG8_WAIT_L(0); PG8_MMA(0, 0, At, B0); PG8_BAR; PG8_SCHED;
            PG8_LDB(B1, 0, 1); PG8_STAGE(PG8_SB(0, 0), b2, voffB);
            PG8_BAR; PG8_WAIT_L(0); PG8_MMA(0, 1, At, B1); PG8_BAR;
            PG8_LDA(At, 0, 1); PG8_STAGE(PG8_SA(0, 0), a2, voffA);
            PG8_BAR; PG8_WAIT_L(0); PG8_MMA(1, 0, At, B0); PG8_BAR; PG8_SCHED;
            PG8_STAGE(PG8_SB(0, 1), b2 + hB, voffB);
            PG8_WAIT_V(6); PG8_BAR; PG8_MMA(1, 1, At, B1); PG8_BAR;
            PG8_LDB(B0, 1, 0); PG8_SCHED; PG8_LDA(At, 1, 0); PG8_STAGE(PG8_SA(0, 1), a2 + hA, voffA);
            PG8_WAIT_L(8); PG8_BAR; PG8_WAIT_L(0); PG8_MMA(0, 0, At, B0); PG8_BAR; PG8_SCHED;
            PG8_LDB(B1, 1, 1); PG8_STAGE(PG8_SB(1, 0), b3, voffB);
            PG8_BAR; PG8_WAIT_L(0); PG8_MMA(0, 1, At, B1); PG8_BAR;
            PG8_LDA(At, 1, 1); PG8_STAGE(PG8_SA(1, 0), a3, voffA);
            PG8_BAR; PG8_WAIT_L(0); PG8_MMA(1, 0, At, B0); PG8_BAR; PG8_SCHED;
            PG8_STAGE(PG8_SB(1, 1), b3 + hB, voffB);
            PG8_WAIT_V(6); PG8_BAR; PG8_MMA(1, 1, At, B1); PG8_BAR;
            }
        }
        if constexpr (ALIGN_EPI) { if (wr == 0) PG8_BAR; }
        if constexpr (!Epi::AFTER_DRAIN) { E(acc, cur, wr, wc, fr, fq); S.done(cur); }
        if (!has_next) break;
#pragma unroll
        for (int a = 0; a < 2; ++a)
#pragma unroll
            for (int b = 0; b < 2; ++b)
#pragma unroll
                for (int m = 0; m < 4; ++m)
#pragma unroll
                    for (int n = 0; n < 2; ++n) acc[a][b][m][n] = (f32x4){0.f, 0.f, 0.f, 0.f};
        cur = nxt; cA = nA; cB = nB; ++ui;
        if constexpr (ALIGN_EPI) { if (wr == 1) PG8_BAR; }
    }
    PG8_WAIT_V(0);
    if constexpr (!ALIGN_EPI) { if (wr == 0) PG8_BAR; }
    PG8_BAR;
    if constexpr (Epi::AFTER_DRAIN) { E.fused(acc, cur, wr, wc, fr, fq, lds, wid, lane); S.done(cur); }
#undef PG8_SA
#undef PG8_SB
#undef PG8_STAGE
#undef PG8_LDA
#undef PG8_LDB
#undef PG8_MMA
#undef PG8_WAIT_V
#undef PG8_WAIT_L
#undef PG8_BAR
#undef PG8_SCHED
}
}
#define GAS __attribute__((address_space(1)))
#define LAS __attribute__((address_space(3)))
typedef unsigned short bf16;
typedef unsigned v4u __attribute__((ext_vector_type(4)));
typedef float f32x4 __attribute__((ext_vector_type(4)));
typedef short bf16x8 __attribute__((ext_vector_type(8)));
typedef GAS unsigned gu32;
typedef GAS unsigned long long gu64;
#define RLX_AGENT __ATOMIC_RELAXED, __HIP_MEMORY_SCOPE_AGENT
#define LDS_WAIT() asm volatile("s_waitcnt lgkmcnt(0)" ::: "memory")
#define VM_WAIT() asm volatile("s_waitcnt vmcnt(0)" ::: "memory")
__device__ __forceinline__ unsigned long long rt() { return __builtin_amdgcn_s_memrealtime(); }
__device__ __forceinline__ unsigned f2bf(float f) { unsigned u = __builtin_bit_cast(unsigned, f); return (u + 0x7fffu + ((u >> 16) & 1u)) >> 16; }
__device__ __forceinline__ unsigned pk2(float lo, float hi) { return f2bf(lo) | (f2bf(hi) << 16); }

#define XB_TMO      128
#define XB_XCNT(j)  (256  + 64 * (j))
#define XB_XSUB(j)  (1280 + 64 * (j))
#define XB_XGEN(j)  (2304 + 64 * (j))
#define XB_TOP      3328
#define XB_TOPGEN   3392
#define XCD_BAR_WORDS 3456
#define XB_SPIN_CAP (1u << 18)

__device__ __forceinline__ unsigned xb_ld(unsigned* p)              { return __hip_atomic_load(p, __ATOMIC_RELAXED, __HIP_MEMORY_SCOPE_AGENT); }
__device__ __forceinline__ unsigned xb_add(unsigned* p, unsigned v) { return __hip_atomic_fetch_add(p, v, __ATOMIC_RELAXED, __HIP_MEMORY_SCOPE_AGENT); }
__device__ __forceinline__ unsigned xb_xcc_id() { return (unsigned)__builtin_amdgcn_s_getreg((3 << 11) | 20) & 0xFu; }
#define XB_SPIN(cond, bar) do { unsigned _sp = 0; while (cond) { __builtin_amdgcn_s_sleep(1); \
    if ((++_sp & 255u) == 0u) { if (xb_ld(&(bar)[XB_TMO])) break; if (_sp > XB_SPIN_CAP) { atomicAdd(&(bar)[XB_TMO], 1u); break; } } } } while (0)

struct XcdBarrier {
    unsigned* bar; unsigned x;
    volatile LAS unsigned* st;
};

__device__ __forceinline__ XcdBarrier xcd_barrier_post(unsigned* bar, volatile LAS unsigned* st) {
    XcdBarrier b; b.bar = bar; b.x = xb_xcc_id(); b.st = st;
    if (threadIdx.x == 0) (void)xb_add(&bar[XB_XCNT(b.x)], 1u);
    return b;
}
__device__ __forceinline__ void xcd_barrier_complete(unsigned* bar, unsigned x, unsigned& nloc, unsigned& nx) {
    const unsigned G = gridDim.x * gridDim.y * gridDim.z;
    unsigned sum, cnt, mine, sp = 0u;
    for (;;) {
        sum = 0u; cnt = 0u; mine = 0u;
#pragma unroll
        for (unsigned j = 0; j < 16; ++j) { const unsigned c = xb_ld(&bar[XB_XCNT(j)]); sum += c; cnt += (c > 0u) ? 1u : 0u; mine = (j == x) ? c : mine; }
        if (sum == G) break;
        __builtin_amdgcn_s_sleep(1);
        if ((++sp & 255u) == 0u) { if (xb_ld(&bar[XB_TMO])) break; if (sp > XB_SPIN_CAP) { atomicAdd(&bar[XB_TMO], 1u); break; } }
    }
    nloc = mine > 0u ? mine : 1u; nx = cnt > 0u ? cnt : 1u;
}

__device__ __forceinline__ void xcd_barrier(const XcdBarrier& b) {
    asm volatile("s_waitcnt vmcnt(0)" ::: "memory");
    __syncthreads();
    if (threadIdx.x == 0) {
        unsigned* bar = b.bar;
        __builtin_amdgcn_s_waitcnt(0);
        unsigned nloc = b.st[0], nx = b.st[1];
        if (nloc == 0u) { xcd_barrier_complete(bar, b.x, nloc, nx); b.st[0] = nloc; b.st[1] = nx; }
        const unsigned old = xb_add(&bar[XB_XSUB(b.x)], 1u);
        const unsigned gen = old / nloc;
        if (old + 1u == (gen + 1u) * nloc) {
            __builtin_amdgcn_fence(__ATOMIC_RELEASE, "agent");
            asm volatile("s_waitcnt vmcnt(0)" ::: "memory");
            const unsigned og = xb_add(&bar[XB_TOP], 1u);
            const unsigned tg = og / nx;
            if (og + 1u == (tg + 1u) * nx) xb_add(&bar[XB_TOPGEN], 1u);
            else XB_SPIN(xb_ld(&bar[XB_TOPGEN]) == tg, bar);
            __builtin_amdgcn_fence(__ATOMIC_ACQUIRE, "agent");
            xb_add(&bar[XB_XGEN(b.x)], 1u);
            asm volatile("s_waitcnt vmcnt(0)" ::: "memory");
        } else {
            XB_SPIN(xb_ld(&bar[XB_XGEN(b.x)]) == gen, bar);
            __builtin_amdgcn_fence(__ATOMIC_ACQUIRE, "agent");
            asm volatile("s_waitcnt vmcnt(0)" ::: "memory");
        }
    }
    __syncthreads();
}
typedef unsigned v2u __attribute__((ext_vector_type(2)));
typedef float v2f __attribute__((ext_vector_type(2)));

constexpr int NWAVES = 8;
constexpr int M = 16384, DM = 2048, SEQ = 2048, DFF = 5632, NH = 11264, WIN_LD = 8720;
using pg8::NZ; using pg8::ZQA; using pg8::ZKA; using pg8::ZVA; using pg8::ZQB; using pg8::ZKB; using pg8::ZVB; using pg8::ZRB; using pg8::ZAL; using pg8::ZGA; using pg8::ZGB;
constexpr int N_PHASES = 19;
constexpr size_t MiB = 1u << 20;
constexpr size_t WS_CTL = 0, CTL_ZERO_BYTES = 1 * MiB;
constexpr size_t WS_SSQ = 1 * MiB;
constexpr size_t WS_ROPE = 3 * MiB;
constexpr size_t WS_WUP = 8 * MiB;
constexpr size_t WS_WDN = 52 * MiB;
constexpr size_t WS_XB = 74 * MiB;
constexpr size_t WS_WIN = 138 * MiB;
constexpr size_t WS_WA = 174 * MiB, WS_WB = 178 * MiB;
constexpr size_t WS_WO = 182 * MiB;
constexpr size_t WS_ZB = 190 * MiB;
constexpr size_t WS_LA = 478 * MiB;
constexpr size_t WS_Y = 510 * MiB;
constexpr size_t WS_MIX = 574 * MiB;
constexpr size_t WS_H = 138 * MiB;
constexpr size_t WS_ACT = 490 * MiB;
constexpr size_t WS_END = 666 * MiB;
static_assert(WS_H + (size_t)M * NH * 2 <= WS_ACT && WS_ACT + (size_t)M * DFF * 2 <= WS_END && WS_MIX + (size_t)M * DM * 2 <= WS_END && WS_ZB + (size_t)M * NZ * 2 <= WS_LA, "ws map");
constexpr int CW_BAR = 4096;
constexpr int RING_OFF = 0, RING_BYTES = 131072;
constexpr int LDSCTL_OFF = RING_BYTES, MISC_OFF = LDSCTL_OFF + 320;
constexpr int LDS_BYTES = 147456;

__device__ __forceinline__ float wave_sum(float v) {
#pragma unroll
    for (int o = 1; o < 64; o <<= 1) v += __shfl_xor(v, o);
    return v;
}
__device__ __forceinline__ float wave_max(float v) {
#pragma unroll
    for (int o = 1; o < 64; o <<= 1) v = fmaxf(v, __shfl_xor(v, o));
    return v;
}
__device__ __forceinline__ float bf2f(bf16 b) { return __uint_as_float(((unsigned)b) << 16); }
__device__ __forceinline__ float bflo(unsigned w) { return __uint_as_float(w << 16); }
__device__ __forceinline__ float bfhi(unsigned w) { return __uint_as_float(w & 0xffff0000u); }
using pg8::cvt_pk_bf16;
__device__ const double ROPE_INVF[8] = {1.0, 0.19392274474868576, 0.03760603093086393, 0.007292664737217109, 0.001414213562373095, 0.0002742481756762073, 5.318295896944988e-05, 1.031338537721246e-05};

__device__ __forceinline__ void transpose_item(const float* W, int ldw, int c0, int k0, const float* gk, bf16* WT, int ldt, int n0, LAS float* scr, int lane) {
#pragma unroll 8
    for (int i = 0; i < 32; ++i) { const int kk = 2 * i + (lane >> 5); float v = W[(size_t)(k0 + kk) * ldw + c0 + (lane & 31)]; if (gk) v *= gk[k0 + kk]; scr[kk * 33 + (lane & 31)] = v; }
    LDS_WAIT(); asm volatile("" ::: "memory");
    const int c = lane & 7;
#pragma unroll
    for (int j = 0; j < 4; ++j) { const int n = (lane >> 3) + 8 * j; const LAS float* s = scr + (8 * c) * 33 + n;
        v4u o; o.x = cvt_pk_bf16(s[0 * 33], s[1 * 33]); o.y = cvt_pk_bf16(s[2 * 33], s[3 * 33]); o.z = cvt_pk_bf16(s[4 * 33], s[5 * 33]); o.w = cvt_pk_bf16(s[6 * 33], s[7 * 33]);
        *(GAS v4u*)(WT + (size_t)(n0 + n) * ldt + k0 + 8 * c) = o; }
    LDS_WAIT(); asm volatile("" ::: "memory");
}
__device__ __forceinline__ void alpha_item(const float* Win, const float* Wau, const float* gk, int k0, int j0, bf16* WT, LAS float* scr, int lane) {
    const int jj = lane & 31;
    float wa[16];
#pragma unroll
    for (int r = 0; r < 16; ++r) wa[r] = Wau[r * 512 + j0 + jj];
#pragma unroll 4
    for (int i = 0; i < 32; ++i) { const int kk = 2 * i + (lane >> 5); const float* wr = Win + (size_t)(k0 + kk) * WIN_LD + 4608; float s = 0.f;
#pragma unroll
        for (int r = 0; r < 16; ++r) s += wr[r] * wa[r];
        scr[kk * 33 + jj] = s * gk[k0 + kk]; }
    LDS_WAIT(); asm volatile("" ::: "memory");
    const int c = lane & 7;
#pragma unroll
    for (int j = 0; j < 4; ++j) { const int n = (lane >> 3) + 8 * j; const LAS float* s = scr + (8 * c) * 33 + n;
        v4u o; o.x = cvt_pk_bf16(s[0 * 33], s[1 * 33]); o.y = cvt_pk_bf16(s[2 * 33], s[3 * 33]); o.z = cvt_pk_bf16(s[4 * 33], s[5 * 33]); o.w = cvt_pk_bf16(s[6 * 33], s[7 * 33]);
        *(GAS v4u*)(WT + (size_t)(ZAL + j0 + n) * DM + k0 + 8 * c) = o; }
    LDS_WAIT(); asm volatile("" ::: "memory");
}

struct LayerIn { const float *gmix, *win, *sink, *wau, *balpha, *ggla, *wa, *wb, *wo, *gffn, *wup, *cw, *cb, *wdn; };

__device__ __forceinline__ void phase_weights(const LayerIn& L, unsigned char* ws, LAS unsigned char* lds, int gw, int NGW, int wave, int lane) {
    LAS float* scr = (LAS float*)(lds + RING_OFF + wave * 16384);
    bf16* WIN = (bf16*)(ws + WS_WIN); bf16* WA = (bf16*)(ws + WS_WA); bf16* WB = (bf16*)(ws + WS_WB); bf16* WO = (bf16*)(ws + WS_WO); bf16* WUP = (bf16*)(ws + WS_WUP); bf16* WDN = (bf16*)(ws + WS_WDN);
    constexpr int I_IN = 272 * 32, I_AL = 16 * 32, I_A = 64 * 16, I_O = 64 * 32, I_UP = 352 * 32, I_DN = 64 * 88;
    constexpr int NITEMS = I_IN + I_AL + 2 * I_A + I_O + I_UP + I_DN;
    for (int it = gw; it < NITEMS; it += NGW) {
        int r = it;
        if (r < I_IN) { const int kb = r / 272, nb = r % 272; const int n0 = nb < 144 ? nb * 32 : 5120 + (nb - 144) * 32; const int c0 = n0 < 4608 ? n0 : n0 - 496;
            transpose_item(L.win, WIN_LD, c0, kb * 64, L.gmix, WIN, DM, n0, scr, lane); continue; } r -= I_IN;
        if (r < I_AL) { const int kb = r / 16, jb = r % 16; alpha_item(L.win, L.wau, L.gmix, kb * 64, jb * 32, WIN, scr, lane); continue; } r -= I_AL;
        if (r < I_A) { const int kb = r / 64, nb = r % 64; transpose_item(L.wa, DM, nb * 32, kb * 64, nullptr, WA, 1024, nb * 32, scr, lane); continue; } r -= I_A;
        if (r < I_A) { const int kb = r / 64, nb = r % 64; transpose_item(L.wb, DM, nb * 32, kb * 64, nullptr, WB, 1024, nb * 32, scr, lane); continue; } r -= I_A;
        if (r < I_O) { const int kb = r / 64, nb = r % 64; transpose_item(L.wo, DM, nb * 32, kb * 64, nullptr, WO, DM, nb * 32, scr, lane); continue; } r -= I_O;
        if (r < I_UP) { const int kb = r / 352, nb = r % 352; const int n0 = nb * 32, pn = n0 >> 8, j0 = n0 & 255; const int c0 = j0 < 128 ? 128 * pn + j0 : DFF + 128 * pn + (j0 - 128);
            transpose_item(L.wup, NH, c0, kb * 64, L.gffn, WUP, DM, n0, scr, lane); continue; } r -= I_UP;
        { const int kb = r / 64, nb = r % 64; transpose_item(L.wdn, DM, nb * 32, kb * 64, nullptr, WDN, DFF, nb * 32, scr, lane); }
    }
}
__device__ __forceinline__ void phase_xprep(const float* x, const int* pos, unsigned char* ws, int gw, int NGW, int lane) {
    bf16* XB = (bf16*)(ws + WS_XB); float* SSQ = (float*)(ws + WS_SSQ); float* CS = (float*)(ws + WS_ROPE);
    for (int m = gw; m < M; m += NGW) {
        const GAS f32x4* xr = (const GAS f32x4*)(x + (size_t)m * DM) + lane;
        f32x4 v[8]; float s = 0.f;
#pragma unroll
        for (int j = 0; j < 8; ++j) { v[j] = xr[64 * j]; s += (v[j].x * v[j].x + v[j].y * v[j].y) + (v[j].z * v[j].z + v[j].w * v[j].w); }
        s = wave_sum(s);
        GAS v2u* o8 = (GAS v2u*)(XB + (size_t)m * DM) + lane;
#pragma unroll
        for (int j = 0; j < 8; ++j) { v2u w; w.x = cvt_pk_bf16(v[j].x, v[j].y); w.y = cvt_pk_bf16(v[j].z, v[j].w); o8[64 * j] = w; }
        if (lane < 32) SSQ[(size_t)m * 32 + lane] = lane == 0 ? s : 0.f;
        if (lane < 8) {
            const double a = (double)pos[m] * ROPE_INVF[lane] * 0.15915494309189535; const float fr = (float)(a - rint(a));
            v2f cs2; cs2.x = __builtin_amdgcn_cosf(fr); cs2.y = __builtin_amdgcn_sinf(fr); *(GAS v2f*)(CS + (size_t)m * 16 + 2 * lane) = cs2;
        }
    }
}

__device__ __forceinline__ float dot8(v4u a, v4u b) {
    return (bflo(a.x) * bflo(b.x) + bfhi(a.x) * bfhi(b.x)) + (bflo(a.y) * bflo(b.y) + bfhi(a.y) * bfhi(b.y)) + (bflo(a.z) * bflo(b.z) + bfhi(a.z) * bfhi(b.z)) + (bflo(a.w) * bflo(b.w) + bfhi(a.w) * bfhi(b.w));
}
__device__ __forceinline__ void swa_simple(const bf16* Z, const float* sink, bf16* Y, int gw, int NGW, int lane) {
    for (int item = gw; item < M * 16; item += NGW) {
        const int row = item >> 4, h = item & 15, hk = h >> 2, t = row & (SEQ - 1);
        const GAS v4u* qp = (const GAS v4u*)(Z + (size_t)row * NZ + ZQA + h * 64);
        v4u qv[8];
#pragma unroll
        for (int i = 0; i < 8; ++i) qv[i] = qp[i];
        float s[2];
#pragma unroll
        for (int hf = 0; hf < 2; ++hf) {
            const int back = hf * 64 + lane; float a = -INFINITY;
            if (t - back >= 0) { const GAS v4u* kp = (const GAS v4u*)(Z + (size_t)(row - back) * NZ + ZKA + hk * 64); a = 0.f;
#pragma unroll
                for (int i = 0; i < 8; ++i) a += dot8(qv[i], kp[i]); }
            s[hf] = a;
        }
        const float sk = sink[h] * pg8::LOG2E;
        const float mx = fmaxf(wave_max(fmaxf(s[0], s[1])), sk);
        const float p0 = __builtin_amdgcn_exp2f(s[0] - mx), p1 = __builtin_amdgcn_exp2f(s[1] - mx);
        const float den = wave_sum(p0 + p1) + __builtin_amdgcn_exp2f(sk - mx);
        float o = 0.f;
        const bf16* vp = Z + (size_t)row * NZ + ZVA + hk * 64 + lane;
#pragma unroll 8
        for (int j = 0; j < 64; ++j) { const float pj = __shfl(p0, j); if (t - j >= 0) o += pj * bf2f(vp[-(ptrdiff_t)j * NZ]); }
#pragma unroll 8
        for (int j = 0; j < 64; ++j) { const float pj = __shfl(p1, j); if (t - 64 - j >= 0) o += pj * bf2f(vp[-(ptrdiff_t)(64 + j) * NZ]); }
        Y[(size_t)row * DM + h * 64 + lane] = (bf16)(cvt_pk_bf16(o / den, 0.f) & 0xffffu);
    }
}
__device__ __forceinline__ void gla_simple(const bf16* Z, const float* LA, float* OS, int gw, int NGW, int lane) {
    for (int item = gw; item < 2048; item += NGW) {
        const int e0 = (item & 63) * 4, h = (item >> 6) & 3, b = item >> 8;
        float S0[4] = {0.f, 0.f, 0.f, 0.f}, S1[4] = {0.f, 0.f, 0.f, 0.f};
        for (int t0 = 0; t0 < SEQ; t0 += 4) {
#pragma unroll
            for (int tt = 0; tt < 4; ++tt) {
                const size_t row = (size_t)b * SEQ + t0 + tt;
                const float a0 = __builtin_amdgcn_exp2f(LA[row * 512 + h * 128 + lane]), a1 = __builtin_amdgcn_exp2f(LA[row * 512 + h * 128 + 64 + lane]);
                const float k0 = bf2f(Z[row * NZ + ZKB + h * 128 + lane]), k1 = bf2f(Z[row * NZ + ZKB + h * 128 + 64 + lane]);
                const float q0 = bf2f(Z[row * NZ + ZQB + h * 128 + lane]), q1 = bf2f(Z[row * NZ + ZQB + h * 128 + 64 + lane]);
                const v2u vv = *(const GAS v2u*)(Z + row * NZ + ZVB + h * 256 + e0);
                const float v[4] = {bflo(vv.x), bfhi(vv.x), bflo(vv.y), bfhi(vv.y)};
                float o[4];
#pragma unroll
                for (int c = 0; c < 4; ++c) { S0[c] = a0 * S0[c] + k0 * v[c]; S1[c] = a1 * S1[c] + k1 * v[c]; o[c] = q0 * S0[c] + q1 * S1[c]; }
#pragma unroll
                for (int c = 0; c < 4; ++c) o[c] = wave_sum(o[c]);
                if (lane == 0) *(GAS f32x4*)(OS + row * 1024 + h * 256 + e0) = (f32x4){o[0], o[1], o[2], o[3]};
            }
        }
    }
}
__device__ __forceinline__ void yb_norm(const float* OS, const bf16* Z, const float* gg, bf16* Y, int gw, int NGW, int lane) {
    const f32x4 g = *(const GAS f32x4*)(gg + 4 * lane);
    for (int item = gw; item < M * 4; item += NGW) {
        const int row = item >> 2, h = item & 3;
        const f32x4 o = *(const GAS f32x4*)(OS + (size_t)row * 1024 + h * 256 + 4 * lane);
        const float ss = wave_sum((o.x * o.x + o.y * o.y) + (o.z * o.z + o.w * o.w));
        const float rs = 1.0f / sqrtf(ss * (1.0f / 256.0f) + pg8::RMS_EPS);
        const v2u r = *(const GAS v2u*)(Z + (size_t)row * NZ + ZRB + h * 256 + 4 * lane);
        v2u w; w.x = cvt_pk_bf16(o.x * rs * g.x * bflo(r.x), o.y * rs * g.y * bfhi(r.x)); w.y = cvt_pk_bf16(o.z * rs * g.z * bflo(r.y), o.w * rs * g.w * bfhi(r.y));
        *(GAS v2u*)(Y + (size_t)row * DM + 1024 + h * 256 + 4 * lane) = w;
    }
}
__device__ __forceinline__ void un8(v4u w, float (&f)[8]) { f[0] = bflo(w.x); f[1] = bfhi(w.x); f[2] = bflo(w.y); f[3] = bfhi(w.y); f[4] = bflo(w.z); f[5] = bfhi(w.z); f[6] = bflo(w.w); f[7] = bfhi(w.w); }
__device__ __forceinline__ void conv_swiglu(const bf16* H, const float* cw, const float* cb, bf16* ACT, int gt, int NT) {
    for (int it = gt; it < 1024 * 704; it += NT) {
        const int rb = it / 704, cg = it % 704, c0 = cg * 8, pn = c0 >> 7, j0 = c0 & 127, hcol = 256 * pn + j0;
        float wg[3][8], wu[3][8], bg[8], bu[8];
#pragma unroll
        for (int j = 0; j < 3; ++j)
#pragma unroll
            for (int q = 0; q < 2; ++q) { const f32x4 a = *(const GAS f32x4*)(cw + (size_t)j * NH + c0 + 4 * q), b = *(const GAS f32x4*)(cw + (size_t)j * NH + DFF + c0 + 4 * q);
#pragma unroll
                for (int i = 0; i < 4; ++i) { wg[j][4 * q + i] = a[i]; wu[j][4 * q + i] = b[i]; } }
#pragma unroll
        for (int q = 0; q < 2; ++q) { const f32x4 a = *(const GAS f32x4*)(cb + c0 + 4 * q), b = *(const GAS f32x4*)(cb + DFF + c0 + 4 * q);
#pragma unroll
            for (int i = 0; i < 4; ++i) { bg[4 * q + i] = a[i]; bu[4 * q + i] = b[i]; } }
        const int row0 = rb * 16;
        float g2[8], g1[8], u2[8], u1[8];
        if ((row0 & (SEQ - 1)) == 0) {
#pragma unroll
            for (int i = 0; i < 8; ++i) { g2[i] = 0.f; g1[i] = 0.f; u2[i] = 0.f; u1[i] = 0.f; }
        } else {
            un8(*(const GAS v4u*)(H + (size_t)(row0 - 2) * NH + hcol), g2); un8(*(const GAS v4u*)(H + (size_t)(row0 - 1) * NH + hcol), g1);
            un8(*(const GAS v4u*)(H + (size_t)(row0 - 2) * NH + hcol + 128), u2); un8(*(const GAS v4u*)(H + (size_t)(row0 - 1) * NH + hcol + 128), u1);
        }
#pragma unroll 4
        for (int r = 0; r < 16; ++r) {
            float g0[8], u0[8], a[8];
            un8(*(const GAS v4u*)(H + (size_t)(row0 + r) * NH + hcol), g0); un8(*(const GAS v4u*)(H + (size_t)(row0 + r) * NH + hcol + 128), u0);
#pragma unroll
            for (int i = 0; i < 8; ++i) {
                const float gc = bg[i] + wg[0][i] * g2[i] + wg[1][i] * g1[i] + wg[2][i] * g0[i];
                const float uc = bu[i] + wu[0][i] * u2[i] + wu[1][i] * u1[i] + wu[2][i] * u0[i];
                a[i] = gc * pg8::sigmoidf_fast(gc) * uc;
                g2[i] = g1[i]; g1[i] = g0[i]; u2[i] = u1[i]; u1[i] = u0[i];
            }
            v4u w; w.x = cvt_pk_bf16(a[0], a[1]); w.y = cvt_pk_bf16(a[2], a[3]); w.z = cvt_pk_bf16(a[4], a[5]); w.w = cvt_pk_bf16(a[6], a[7]);
            *(GAS v4u*)(ACT + (size_t)(row0 + r) * DFF + c0) = w;
        }
    }
}
__device__ __forceinline__ void final_norm(float* out, const float* fg, int gw, int NGW, int lane) {
    for (int m = gw; m < M; m += NGW) {
        GAS f32x4* xr = (GAS f32x4*)(out + (size_t)m * DM) + lane; const GAS f32x4* gr = (const GAS f32x4*)fg + lane;
        f32x4 v[8]; float s = 0.f;
#pragma unroll
        for (int j = 0; j < 8; ++j) { v[j] = xr[64 * j]; s += (v[j].x * v[j].x + v[j].y * v[j].y) + (v[j].z * v[j].z + v[j].w * v[j].w); }
        const float rs = 1.0f / sqrtf(wave_sum(s) * (1.0f / DM) + pg8::RMS_EPS);
#pragma unroll
        for (int j = 0; j < 8; ++j) xr[64 * j] = v[j] * rs * gr[64 * j];
    }
}

struct Args { const void* in[17]; float* out; unsigned char* ws; int ph_lo, ph_hi; };
__global__ void __launch_bounds__(NWAVES * 64, 2) fwd(Args args) {
    extern __shared__ __attribute__((aligned(16))) unsigned char lds_raw[];
    LAS unsigned char* lds = (LAS unsigned char*)lds_raw;
    volatile LAS unsigned* MISC = (volatile LAS unsigned*)(lds + MISC_OFF);
    const int tid = threadIdx.x, lane = tid & 63, wave = __builtin_amdgcn_readfirstlane(tid >> 6);
    const int G = gridDim.x, NGW = G * NWAVES, NT = G * NWAVES * 64; (void)lane; (void)wave;
    unsigned char* ws = args.ws;
    gu32* ctl = (gu32*)(ws + WS_CTL);
    for (int u = tid; u < (LDS_BYTES - LDSCTL_OFF) / 4; u += NWAVES * 64) ((LAS unsigned*)(lds + LDSCTL_OFF))[u] = 0u;
    __syncthreads();
    XcdBarrier bar = xcd_barrier_post((unsigned*)(ctl + CW_BAR), MISC + 8);
    const int lo = args.ph_lo, hi = args.ph_hi;
#define IN(p) (lo <= (p) && (p) < hi)
#define SEAM(p) do { if (IN(p) && IN((p) + 1)) xcd_barrier(bar); } while (0)

    for (int l = 0; l < 2; ++l) {
        const int pb = 9 * l;
#define INP(k) ((const float*)args.in[k])
#define PHASE_IDS() int tidp = threadIdx.x; asm volatile("" : "+v"(tidp)); const int lanep = tidp & 63, wavep = __builtin_amdgcn_readfirstlane(tidp >> 6), gwp = blockIdx.x * NWAVES + wavep, gtp = blockIdx.x * (NWAVES * 64) + tidp; (void)lanep; (void)gwp; (void)gtp
        if (IN(pb + 0)) { PHASE_IDS();
            LayerIn L;
            L.gmix = INP(2) + (size_t)l * DM; L.win = INP(3) + (size_t)l * DM * WIN_LD; L.wau = INP(5) + (size_t)l * 16 * 512;
            L.wa = INP(8) + (size_t)l * 1024 * DM; L.wb = INP(9) + (size_t)l * 1024 * DM; L.wo = INP(10) + (size_t)l * DM * DM;
            L.gffn = INP(11) + (size_t)l * DM; L.wup = INP(12) + (size_t)l * DM * NH; L.wdn = INP(15) + (size_t)l * DFF * DM;
            phase_weights(L, ws, lds, gwp, NGW, wavep, lanep);
            if (l == 0) phase_xprep(INP(0), (const int*)args.in[1], ws, gwp, NGW, lanep);
        }
        SEAM(pb + 0);
        if (IN(pb + 1)) { PHASE_IDS();
            pg8::Gemm g{(bf16*)(ws + WS_XB), (bf16*)(ws + WS_WIN), M, NZ, DM, DM}; pg8::StaticOrder S; S.init(M, NZ, G, (int)blockIdx.x);
            pg8::EpiZ E{(bf16*)(ws + WS_ZB), (float*)(ws + WS_LA), (float*)(ws + WS_SSQ), (float*)(ws + WS_ROPE), INP(6) + l * 512};
            pg8::gemm_phase<pg8::EpiZ, pg8::StaticOrder, true, true>(lds + RING_OFF, g, S, E, tidp);
        }
        SEAM(pb + 1);
        if (IN(pb + 2)) { PHASE_IDS(); swa_simple((bf16*)(ws + WS_ZB), INP(4) + l * 16, (bf16*)(ws + WS_Y), gwp, NGW, lanep); gla_simple((bf16*)(ws + WS_ZB), (float*)(ws + WS_LA), (float*)(ws + WS_XB), gwp, NGW, lanep); }
        SEAM(pb + 2);
        if (IN(pb + 3)) { PHASE_IDS();
            yb_norm((float*)(ws + WS_XB), (bf16*)(ws + WS_ZB), INP(7) + l * 256, (bf16*)(ws + WS_Y), gwp, NGW, lanep);
            pg8::Gemm g{(bf16*)(ws + WS_Y), (bf16*)(ws + WS_WA), M, DM, 1024, DM}; pg8::StaticOrder S; S.init(M, DM, G, (int)blockIdx.x);
            pg8::EpiGate<false> E{(bf16*)(ws + WS_MIX), (bf16*)(ws + WS_ZB) + ZGA};
            pg8::gemm_phase<pg8::EpiGate<false>, pg8::StaticOrder, true, true>(lds + RING_OFF, g, S, E, tidp);
        }
        SEAM(pb + 3);
        if (IN(pb + 4)) { PHASE_IDS();
            pg8::Gemm g{(bf16*)(ws + WS_Y) + 1024, (bf16*)(ws + WS_WB), M, DM, 1024, DM}; pg8::StaticOrder S; S.init(M, DM, G, (int)blockIdx.x);
            pg8::EpiGate<true> E{(bf16*)(ws + WS_MIX), (bf16*)(ws + WS_ZB) + ZGB};
            pg8::gemm_phase<pg8::EpiGate<true>, pg8::StaticOrder, true, true>(lds + RING_OFF, g, S, E, tidp);
        }
        SEAM(pb + 4);
        if (IN(pb + 5)) { PHASE_IDS();
            pg8::Gemm g{(bf16*)(ws + WS_MIX), (bf16*)(ws + WS_WO), M, DM, DM, DM}; pg8::StaticOrder S; S.init(M, DM, G, (int)blockIdx.x);
            pg8::EpiRes E{(l == 0) ? INP(0) : (const float*)args.out, args.out, (bf16*)(ws + WS_XB), (float*)(ws + WS_SSQ)};
            pg8::gemm_phase<pg8::EpiRes, pg8::StaticOrder, true, true>(lds + RING_OFF, g, S, E, tidp);
        }
        SEAM(pb + 5);
        if (IN(pb + 6)) { PHASE_IDS();
            pg8::Gemm g{(bf16*)(ws + WS_XB), (bf16*)(ws + WS_WUP), M, NH, DM, DM}; pg8::StaticOrder S; S.init(M, NH, G, (int)blockIdx.x);
            pg8::EpiH E{(bf16*)(ws + WS_H), NH, (float*)(ws + WS_SSQ)};
            pg8::gemm_phase<pg8::EpiH, pg8::StaticOrder, true, true>(lds + RING_OFF, g, S, E, tidp);
        }
        SEAM(pb + 6);
        if (IN(pb + 7)) { PHASE_IDS(); conv_swiglu((bf16*)(ws + WS_H), INP(13) + (size_t)l * 3 * NH, INP(14) + (size_t)l * NH, (bf16*)(ws + WS_ACT), gtp, NT); }
        SEAM(pb + 7);
        if (IN(pb + 8)) { PHASE_IDS();
            pg8::Gemm g{(bf16*)(ws + WS_ACT), (bf16*)(ws + WS_WDN), M, DM, DFF, DFF}; pg8::StaticOrder S; S.init(M, DM, G, (int)blockIdx.x);
            pg8::EpiRes E{args.out, args.out, (bf16*)(ws + WS_XB), (float*)(ws + WS_SSQ)};
            pg8::gemm_phase<pg8::EpiRes, pg8::StaticOrder, true, true>(lds + RING_OFF, g, S, E, tidp);
        }
        SEAM(pb + 8);
    }
    if (IN(18)) { PHASE_IDS(); final_norm(args.out, (const float*)args.in[16], gwp, NGW, lanep); }
#undef IN
#undef SEAM
}

#ifndef N_LAUNCH_MODE
#define N_LAUNCH_MODE 19
#endif
extern "C" void kernel_launch(void* const* d_in, const int* in_sizes, int n_in, void* d_out, int out_size, void* d_ws, size_t ws_size, hipStream_t stream) {
    static int grid = 0;
    if (grid == 0) {
        if (n_in != 17 || out_size != M * DM || ws_size < WS_END) { fprintf(stderr, "kernel_launch: unexpected shapes (n_in %d out %d ws %zu)\n", n_in, out_size, ws_size); grid = -1; return; }
        int dev = 0, cus = 0, per_cu = 0;
        if (hipGetDevice(&dev) != hipSuccess || hipDeviceGetAttribute(&cus, hipDeviceAttributeMultiprocessorCount, dev) != hipSuccess) { grid = -1; return; }
        if (hipFuncSetAttribute((const void*)fwd, hipFuncAttributeMaxDynamicSharedMemorySize, LDS_BYTES) != hipSuccess) { fprintf(stderr, "kernel_launch: hipFuncSetAttribute failed\n"); grid = -1; return; }
        if (hipOccupancyMaxActiveBlocksPerMultiprocessor(&per_cu, (const void*)fwd, NWAVES * 64, LDS_BYTES) != hipSuccess || per_cu < 1) fprintf(stderr, "kernel_launch: occupancy query reports %d\n", per_cu);
        (void)hipGetLastError();
        grid = cus;
    }
    if (grid < 0) return;
    if (hipMemsetAsync((char*)d_ws + WS_CTL, 0, CTL_ZERO_BYTES, stream) != hipSuccess) return;
    Args a{};
    for (int i = 0; i < 17; ++i) a.in[i] = d_in[i];
    a.out = (float*)d_out; a.ws = (unsigned char*)d_ws;
    if (N_LAUNCH_MODE == 1) { a.ph_lo = 0; a.ph_hi = N_PHASES; hipLaunchKernelGGL(fwd, dim3(grid), dim3(NWAVES * 64), LDS_BYTES, stream, a); }
    else for (int p = 0; p < N_PHASES; ++p) { a.ph_lo = p; a.ph_hi = p + 1; hipLaunchKernelGGL(fwd, dim3(grid), dim3(NWAVES * 64), LDS_BYTES, stream, a); }
}
```

```cpp
#include <hip/hip_runtime.h>
#include <cstdio>
#include <cstdint>
#include <cmath>
namespace pg8 {
#define PG8_LAS __attribute__((address_space(3)))
typedef unsigned short bf16_t;
typedef short bf16x8 __attribute__((ext_vector_type(8)));
typedef float f32x4 __attribute__((ext_vector_type(4)));
typedef unsigned u32x4 __attribute__((ext_vector_type(4)));
constexpr int BM = 256, BK = 64, HALF = 128, HTB = HALF * BK * 2  , STAGE_BYTES = 8 * HTB, NXCD = 8, WGM = 8;

__host__ __device__ __forceinline__ int lds_byte(int r, int c) { const int st = (r >> 4) * 2 + (c >> 5), rr = r & 15, cc = c & 31, ob = rr * 64 + cc * 2; return st * 1024 + (ob ^ (((ob >> 9) & 1) << 5)); }
__host__ __device__ __forceinline__ void stage_rc(int b, int& R, int& C) { const int st = b / 1024, sb = b % 1024, swz = sb ^ (((sb >> 9) & 1) << 5); R = (st >> 1) * 16 + swz / 64; C = (st & 1) * 32 + (swz % 64) / 2; }
__host__ __device__ __forceinline__ int perm32(int rho) { const int n = rho >> 4, i = rho & 15; return 8 * (i >> 2) + 4 * n + (i & 3); }

struct Unit { int pm, pn, seg; };
struct Gemm { const bf16_t* A; const bf16_t* Bt; int M, N, K, lda; const bf16_t* A1; const bf16_t* Bt1; };

struct StaticOrder {
    int nM, nN, nwg, G, c;
    __host__ __device__ void init(int M, int N, int G_, int c_) { nM = M / BM; nN = N / BM; nwg = nM * nN; G = G_; c = c_; }
    __host__ __device__ bool next(int i, Unit& u) const {
        const long L = (long)i * G + c; if (L >= nwg) return false;
        int wgid = (int)L; { const int q = nwg / NXCD, r = nwg % NXCD, xcd = wgid % NXCD, off = wgid / NXCD; wgid = (xcd < r ? xcd * (q + 1) : r * (q + 1) + (xcd - r) * q) + off; }
        const int nig = WGM * nN, gid = wgid / nig, fm = gid * WGM, gsz = (nM - fm) < WGM ? (nM - fm) : WGM;
        u.pm = fm + ((wgid % nig) % gsz); u.pn = (wgid % nig) / gsz; u.seg = 0; return true;
    }
    __device__ __forceinline__ void a_ready(const Unit&) const {}
    __device__ __forceinline__ void done(const Unit&) const {}
};

struct TwoSegOrder : StaticOrder {
    __host__ __device__ bool next(int i, Unit& u) const { if (!StaticOrder::next(i >> 1, u)) return false; u.seg = i & 1; return true; }
};
typedef float f32x2_t __attribute__((ext_vector_type(2))); typedef __bf16 bf16x2_t __attribute__((ext_vector_type(2)));
__device__ __forceinline__ unsigned cvt_pk_bf16(float lo, float hi) { const f32x2_t v = {lo, hi}; const bf16x2_t b = __builtin_convertvector(v, bf16x2_t); return __builtin_bit_cast(unsigned, b); }
__device__ __forceinline__ u32x4 pack8(f32x4 a, f32x4 b) { u32x4 w; w.x = cvt_pk_bf16(a[0], a[1]); w.y = cvt_pk_bf16(a[2], a[3]); w.z = cvt_pk_bf16(b[0], b[1]); w.w = cvt_pk_bf16(b[2], b[3]); return w; }
__device__ __forceinline__ f32x4 unlo(u32x4 w) { return (f32x4){__uint_as_float(w.x << 16), __uint_as_float(w.x & 0xffff0000u), __uint_as_float(w.y << 16), __uint_as_float(w.y & 0xffff0000u)}; }
__device__ __forceinline__ f32x4 unhi(u32x4 w) { return (f32x4){__uint_as_float(w.z << 16), __uint_as_float(w.z & 0xffff0000u), __uint_as_float(w.w << 16), __uint_as_float(w.w & 0xffff0000u)}; }

constexpr int NZ = 9216;
constexpr int ZQA = 0, ZKA = 1024, ZVA = 1280, ZQB = 1536, ZKB = 2048, ZVB = 2560, ZRB = 3584, ZAL = 4608, ZGA = 5120, ZGB = 7168;
constexpr float LOG2E = 1.4426950408889634f;
constexpr float QA_SCALE = 0.125f * LOG2E;
constexpr float QB_SCALE = 0.08838834764831845f;
constexpr float RMS_EPS = 1e-6f;

__device__ __forceinline__ float row_rstd(const float* ssq, int row, int fq) {
    const f32x4* p = (const f32x4*)(ssq + (size_t)row * 32 + fq * 8);
    const f32x4 a = p[0], b = p[1];
    float s = ((a[0] + a[1]) + (a[2] + a[3])) + ((b[0] + b[1]) + (b[2] + b[3]));
    s += __shfl_xor(s, 16); s += __shfl_xor(s, 32);
    return 1.0f / sqrtf(s * (1.0f / 2048.0f) + RMS_EPS);
}
__device__ __forceinline__ float sigmoidf_fast(float x) { return __builtin_amdgcn_rcpf(1.0f + __expf(-x)); }

template <int CTRL, bool ZFILL> __device__ __forceinline__ float dppf(float x) { return __builtin_bit_cast(float, __builtin_amdgcn_update_dpp(0, __builtin_bit_cast(int, x), CTRL, 0xf, 0xf, ZFILL)); }
struct EpiZ {
    static constexpr bool PERM = true, AFTER_DRAIN = false; static __device__ __forceinline__ bool keeps_acc(const Unit&) { return false; }
    bf16_t* Z; float* LA; const PG8_LAS float* rsl; const float* cs; const float* balpha;
    __device__ __forceinline__ void operator()(const f32x4 (&acc)[2][2][4][2], const Unit& u, int wr, int wc, int fr, int fq) const {
        const int pn = u.pn, row0 = u.pm * BM + wr * 64 + fr, colw = wc * 32 + 8 * fq;
        float rs[2][4];
#pragma unroll
        for (int ai = 0; ai < 2; ++ai)
#pragma unroll
            for (int m = 0; m < 4; ++m) rs[ai][m] = rsl[(row0 + ai * HALF + m * 16) & 2047];
        if (pn < 5) {
            const bool rot = (wc & 1) == 0;
            const float post = pn < 4 ? QA_SCALE : 1.0f;
            const float sgn = fq == 0 ? -1.0f : (fq == 1 ? 1.0f : 0.0f);
#pragma unroll
            for (int ai = 0; ai < 2; ++ai)
#pragma unroll
            for (int mb = 0; mb < 4; mb += 2) {
                f32x4 ct[2][4];
                if (rot) {
#pragma unroll
                    for (int mm = 0; mm < 2; ++mm) { const f32x4* cp = (const f32x4*)(cs + (size_t)(row0 + ai * HALF + (mb + mm) * 16) * 16);
#pragma unroll
                        for (int q = 0; q < 4; ++q) ct[mm][q] = cp[q]; }
                }
                asm volatile("" ::: "memory");
#pragma unroll
                for (int mm = 0; mm < 2; ++mm) {
                    const int m = mb + mm, row = row0 + ai * HALF + m * 16;
                    const float sc = rs[ai][m] * post;
                    f32x4 v[2][2];
#pragma unroll
                    for (int bj = 0; bj < 2; ++bj)
#pragma unroll
                        for (int n = 0; n < 2; ++n) v[bj][n] = acc[ai][bj][m][n] * sc;
                    if (rot) {
                        float cc[8], sn[8];
#pragma unroll
                        for (int j = 0; j < 8; ++j) { cc[j] = fq < 2 ? ct[mm][j >> 1][2 * (j & 1)] : 1.0f; sn[j] = ct[mm][j >> 1][2 * (j & 1) + 1] * sgn; }
#pragma unroll
                        for (int bj = 0; bj < 2; ++bj)
#pragma unroll
                            for (int n = 0; n < 2; ++n)
#pragma unroll
                                for (int i = 0; i < 4; ++i) { const float own = v[bj][n][i], oth = __shfl_xor(own, 16); v[bj][n][i] = own * cc[4 * n + i] + oth * sn[4 * n + i]; }
                    }
                    bf16_t* rowp = Z + (size_t)row * NZ + pn * BM + colw;
#pragma unroll
                    for (int bj = 0; bj < 2; ++bj) *(u32x4*)(rowp + bj * HALF) = pack8(v[bj][0], v[bj][1]);
                }
                asm volatile("" ::: "memory");
            }
        } else if (pn == 18 || pn == 19) {
            f32x4 bb[2][2];
#pragma unroll
            for (int bj = 0; bj < 2; ++bj)
#pragma unroll
                for (int n = 0; n < 2; ++n) bb[bj][n] = *(const f32x4*)(balpha + (pn - 18) * 256 + bj * HALF + colw + 4 * n);
            const int l15 = (fq * 16 + 15) * 4;
#pragma unroll
            for (int ai = 0; ai < 2; ++ai)
#pragma unroll
                for (int bj = 0; bj < 2; ++bj)
#pragma unroll
                    for (int n = 0; n < 2; ++n) {
                        f32x4 carry = {0.f, 0.f, 0.f, 0.f};
#pragma unroll
                        for (int m = 0; m < 4; ++m) {
                            float s0, s1, s2, s3;
                            {
                                const f32x4 x = acc[ai][bj][m][n] * rs[ai][m] + bb[bj][n];
                                s0 = fminf(x[0], 0.0f) * (LOG2E / 16.0f) - __builtin_amdgcn_logf(1.0f + __builtin_amdgcn_exp2f(-fabsf(x[0]) * LOG2E)) * (1.0f / 16.0f);
                                s1 = fminf(x[1], 0.0f) * (LOG2E / 16.0f) - __builtin_amdgcn_logf(1.0f + __builtin_amdgcn_exp2f(-fabsf(x[1]) * LOG2E)) * (1.0f / 16.0f);
                                s2 = fminf(x[2], 0.0f) * (LOG2E / 16.0f) - __builtin_amdgcn_logf(1.0f + __builtin_amdgcn_exp2f(-fabsf(x[2]) * LOG2E)) * (1.0f / 16.0f);
                                s3 = fminf(x[3], 0.0f) * (LOG2E / 16.0f) - __builtin_amdgcn_logf(1.0f + __builtin_amdgcn_exp2f(-fabsf(x[3]) * LOG2E)) * (1.0f / 16.0f);
                            }
                            asm volatile("s_nop 1\n\t"
                                         "v_add_f32_dpp %0, %0, %0 row_shr:1 row_mask:0xf bank_mask:0xf bound_ctrl:0\n\tv_add_f32_dpp %1, %1, %1 row_shr:1 row_mask:0xf bank_mask:0xf bound_ctrl:0\n\t"
                                         "v_add_f32_dpp %2, %2, %2 row_shr:1 row_mask:0xf bank_mask:0xf bound_ctrl:0\n\tv_add_f32_dpp %3, %3, %3 row_shr:1 row_mask:0xf bank_mask:0xf bound_ctrl:0\n\t"
                                         "v_add_f32_dpp %0, %0, %0 row_shr:2 row_mask:0xf bank_mask:0xf bound_ctrl:0\n\tv_add_f32_dpp %1, %1, %1 row_shr:2 row_mask:0xf bank_mask:0xf bound_ctrl:0\n\t"
                                         "v_add_f32_dpp %2, %2, %2 row_shr:2 row_mask:0xf bank_mask:0xf bound_ctrl:0\n\tv_add_f32_dpp %3, %3, %3 row_shr:2 row_mask:0xf bank_mask:0xf bound_ctrl:0\n\t"
                                         "v_add_f32_dpp %0, %0, %0 row_shr:4 row_mask:0xf bank_mask:0xf bound_ctrl:0\n\tv_add_f32_dpp %1, %1, %1 row_shr:4 row_mask:0xf bank_mask:0xf bound_ctrl:0\n\t"
                                         "v_add_f32_dpp %2, %2, %2 row_shr:4 row_mask:0xf bank_mask:0xf bound_ctrl:0\n\tv_add_f32_dpp %3, %3, %3 row_shr:4 row_mask:0xf bank_mask:0xf bound_ctrl:0\n\t"
                                         "v_add_f32_dpp %0, %0, %0 row_shr:8 row_mask:0xf bank_mask:0xf bound_ctrl:0\n\tv_add_f32_dpp %1, %1, %1 row_shr:8 row_mask:0xf bank_mask:0xf bound_ctrl:0\n\t"
                                         "v_add_f32_dpp %2, %2, %2 row_shr:8 row_mask:0xf bank_mask:0xf bound_ctrl:0\n\tv_add_f32_dpp %3, %3, %3 row_shr:8 row_mask:0xf bank_mask:0xf bound_ctrl:0\n\t"
                                         "s_nop 1"
                                         : "+v"(s0), "+v"(s1), "+v"(s2), "+v"(s3));
                            const f32x4 sc = {s0, s1, s2, s3};
                            f32x4 tt;
                            tt[0] = __builtin_bit_cast(float, __builtin_amdgcn_ds_bpermute(l15, __builtin_bit_cast(int, s0))); tt[1] = __builtin_bit_cast(float, __builtin_amdgcn_ds_bpermute(l15, __builtin_bit_cast(int, s1)));
                            tt[2] = __builtin_bit_cast(float, __builtin_amdgcn_ds_bpermute(l15, __builtin_bit_cast(int, s2))); tt[3] = __builtin_bit_cast(float, __builtin_amdgcn_ds_bpermute(l15, __builtin_bit_cast(int, s3)));
                            *(f32x4*)(LA + (size_t)(row0 + ai * HALF + m * 16) * 512 + (pn - 18) * 256 + bj * HALF + colw + 4 * n) = sc + carry;
                            carry = carry + tt;
                        }
                    }
        } else {
            const int mode = pn < 14 ? 0 : (pn < 18 ? 1 : 2);
            const float post = (pn == 6 || pn == 7) ? QB_SCALE : 1.0f;
#pragma unroll
            for (int ai = 0; ai < 2; ++ai)
#pragma unroll
                for (int m = 0; m < 4; ++m) {
                    const int row = row0 + ai * HALF + m * 16;
                    const float sc = rs[ai][m] * post, sce = rs[ai][m] * -LOG2E;
                    f32x4 v[2][2];
#pragma unroll
                    for (int bj = 0; bj < 2; ++bj)
#pragma unroll
                        for (int n = 0; n < 2; ++n) {
                            if (mode == 0) v[bj][n] = acc[ai][bj][m][n] * sc;
                            else {
#pragma unroll
                                for (int i = 0; i < 4; ++i) { const float a = acc[ai][bj][m][n][i], sg = __builtin_amdgcn_rcpf(1.0f + __builtin_amdgcn_exp2f(a * sce)); v[bj][n][i] = mode == 1 ? (a * sc) * sg : sg; }
                            }
                        }
                    bf16_t* rowp = Z + (size_t)row * NZ + pn * BM + colw;
#pragma unroll
                    for (int bj = 0; bj < 2; ++bj) *(u32x4*)(rowp + bj * HALF) = pack8(v[bj][0], v[bj][1]);
                }
        }
    }
};
struct EpiMix {
    static constexpr bool PERM = true, AFTER_DRAIN = false; static __device__ __forceinline__ bool keeps_acc(const Unit& u) { return u.seg == 0; }
    bf16_t* O; const bf16_t* GA; const bf16_t* GB;
    __device__ __forceinline__ void operator()(f32x4 (&acc)[2][2][4][2], const Unit& u, int wr, int wc, int fr, int fq) const {
        const int row0 = u.pm * BM + wr * 64 + fr, col0 = u.pn * BM + wc * 32 + 8 * fq;
        if (u.seg == 0) {
#pragma unroll
            for (int ai = 0; ai < 2; ++ai)
#pragma unroll
                for (int mb = 0; mb < 4; mb += 2) {
                    u32x4 ga[2][2], gb[2][2];
#pragma unroll
                    for (int mm = 0; mm < 2; ++mm)
#pragma unroll
                        for (int bj = 0; bj < 2; ++bj) { const size_t off = (size_t)(row0 + ai * HALF + (mb + mm) * 16) * NZ + col0 + bj * HALF; ga[mm][bj] = *(const u32x4*)(GA + off); gb[mm][bj] = *(const u32x4*)(GB + off); }
#pragma unroll
                    for (int mm = 0; mm < 2; ++mm)
#pragma unroll
                        for (int bj = 0; bj < 2; ++bj) { const int m = mb + mm;
                            const f32x4 a0 = unlo(ga[mm][bj]), a1 = unhi(ga[mm][bj]), b0 = unlo(gb[mm][bj]), b1 = unhi(gb[mm][bj]);
#pragma unroll
                            for (int i = 0; i < 4; ++i) { const float t0 = __uint_as_float(cvt_pk_bf16(acc[ai][bj][m][0][i] * a0[i], 0.f) << 16), t1 = __uint_as_float(cvt_pk_bf16(acc[ai][bj][m][1][i] * a1[i], 0.f) << 16); acc[ai][bj][m][0][i] = t0 * __builtin_amdgcn_rcpf(fmaxf(b0[i], 1e-20f)); acc[ai][bj][m][1][i] = t1 * __builtin_amdgcn_rcpf(fmaxf(b1[i], 1e-20f)); } }
                }
        } else {
#pragma unroll
            for (int ai = 0; ai < 2; ++ai) {
                u32x4 gb[4][2];
#pragma unroll
                for (int m = 0; m < 4; ++m)
#pragma unroll
                    for (int bj = 0; bj < 2; ++bj) gb[m][bj] = *(const u32x4*)(GB + (size_t)(row0 + ai * HALF + m * 16) * NZ + col0 + bj * HALF);
                asm volatile("" ::: "memory");
#pragma unroll
                for (int m = 0; m < 4; ++m)
#pragma unroll
                    for (int bj = 0; bj < 2; ++bj) *(u32x4*)(O + (size_t)(row0 + ai * HALF + m * 16) * 2048 + col0 + bj * HALF) = pack8(acc[ai][bj][m][0] * unlo(gb[m][bj]), acc[ai][bj][m][1] * unhi(gb[m][bj]));
                asm volatile("" ::: "memory");
            }
        }
    }
};
struct EpiRes {
    static constexpr bool PERM = true, AFTER_DRAIN = false; static __device__ __forceinline__ bool keeps_acc(const Unit&) { return false; }
    bf16_t* xb; float* ssq;
    __device__ __forceinline__ void operator()(const f32x4 (&acc)[2][2][4][2], const Unit& u, int wr, int wc, int fr, int fq) const {
        const int row0 = u.pm * BM + wr * 64 + fr, col0 = u.pn * BM + wc * 32 + 8 * fq;
        float sqs[2][4];
#pragma unroll
        for (int ai = 0; ai < 2; ++ai) {
            u32x4 rv[4][2];
#pragma unroll
            for (int m = 0; m < 4; ++m)
#pragma unroll
                for (int bj = 0; bj < 2; ++bj) rv[m][bj] = *(const u32x4*)(xb + (size_t)(row0 + ai * HALF + m * 16) * 2048 + col0 + bj * HALF);
            asm volatile("" ::: "memory");
#pragma unroll
            for (int m = 0; m < 4; ++m) {
                const int row = row0 + ai * HALF + m * 16;
                float sq = 0.0f;
#pragma unroll
                for (int bj = 0; bj < 2; ++bj) {
                    const f32x4 x0 = unlo(rv[m][bj]) + acc[ai][bj][m][0], x1 = unhi(rv[m][bj]) + acc[ai][bj][m][1];
                    sq += ((x0[0] * x0[0] + x0[1] * x0[1]) + (x0[2] * x0[2] + x0[3] * x0[3])) + ((x1[0] * x1[0] + x1[1] * x1[1]) + (x1[2] * x1[2] + x1[3] * x1[3]));
                    *(u32x4*)(xb + (size_t)row * 2048 + col0 + bj * HALF) = pack8(x0, x1);
                }
                sq += __shfl_xor(sq, 16); sq += __shfl_xor(sq, 32);
                sqs[ai][m] = sq;
            }
            asm volatile("" ::: "memory");
        }
#pragma unroll
        for (int ai = 0; ai < 2; ++ai) { const float v = fq == 0 ? sqs[ai][0] : (fq == 1 ? sqs[ai][1] : (fq == 2 ? sqs[ai][2] : sqs[ai][3]));
            ssq[(size_t)(row0 + ai * HALF + fq * 16) * 32 + u.pn * 4 + wc] = v; }
    }
};
__device__ __forceinline__ unsigned dpp_ror1(unsigned x) { return (unsigned)__builtin_amdgcn_mov_dpp((int)x, 0x121, 0xf, 0xf, false); }
__device__ __forceinline__ unsigned dpp_ror2(unsigned x) { return (unsigned)__builtin_amdgcn_mov_dpp((int)x, 0x122, 0xf, 0xf, false); }
__device__ __forceinline__ unsigned dpp_shr1(unsigned old, unsigned x) { return (unsigned)__builtin_amdgcn_update_dpp((int)old, (int)x, 0x111, 0xf, 0xf, false); }
__device__ __forceinline__ unsigned dpp_shr2(unsigned old, unsigned x) { return (unsigned)__builtin_amdgcn_update_dpp((int)old, (int)x, 0x112, 0xf, 0xf, false); }
typedef unsigned u32x2 __attribute__((ext_vector_type(2)));
typedef _Float16 f16x2_t __attribute__((ext_vector_type(2)));
__device__ __forceinline__ unsigned cvt_pk_f16(float lo, float hi) { const f32x2_t v = {lo, hi}; const f16x2_t h = __builtin_convertvector(v, f16x2_t); return __builtin_bit_cast(unsigned, h); }
__device__ __forceinline__ f16x2_t as_h2(unsigned x) { return __builtin_bit_cast(f16x2_t, x); }
__device__ __forceinline__ unsigned h2_bits(f16x2_t x) { return __builtin_bit_cast(unsigned, x); }
constexpr float LN2 = 0.6931471805599453f;
struct EpiUp {
    static constexpr bool PERM = true, AFTER_DRAIN = false; static __device__ __forceinline__ bool keeps_acc(const Unit&) { return false; }
    bf16_t* ACT; const PG8_LAS float* rsl; PG8_LAS unsigned* xl; PG8_LAS unsigned* cwl; const float* cw; const float* cb; bf16_t* HF; bf16_t* HL;
    __device__ __forceinline__ void operator()(const f32x4 (&acc)[2][2][4][2], const Unit& u, int wr, int wc, int fr, int fq) const {
        const int pn = u.pn, row0 = u.pm * BM + wr * 64 + fr, colw = wc * 32 + 8 * fq, c0 = 128 * pn + colw;
        {
            const int t = (wr * 4 + wc) * 64 + fq * 16 + fr, kind = t >> 6, cc = 2 * (t & 63), gu = kind >> 2, j = kind & 3;
            const float* src = (j < 3 ? cw + (size_t)j * 11264 : cb) + gu * 5632 + 128 * pn + cc;
            const float sc = gu == 0 ? -LOG2E : -LN2;
            cwl[t] = cvt_pk_f16(src[0] * sc, src[1] * sc);
        }
        u32x2 hp[2][2][4][2];
#pragma unroll
        for (int ai = 0; ai < 2; ++ai)
#pragma unroll
            for (int m = 0; m < 4; ++m) { const float rs = rsl[(row0 + ai * HALF + m * 16) & 2047];
#pragma unroll
                for (int gu = 0; gu < 2; ++gu)
#pragma unroll
                    for (int n = 0; n < 2; ++n) { const f32x4 v = acc[ai][gu][m][n] * rs; hp[ai][gu][m][n].x = cvt_pk_f16(v[0], v[1]); hp[ai][gu][m][n].y = cvt_pk_f16(v[2], v[3]); } }
        if (fr >= 14) {
#pragma unroll
            for (int ai = 0; ai < 2; ++ai)
#pragma unroll
                for (int gu = 0; gu < 2; ++gu)
#pragma unroll
                    for (int n = 0; n < 2; ++n) { *(PG8_LAS u32x2*)(xl + ((((2 * ai + wr) * 2 + (fr - 14)) * 256 + 128 * gu + colw + 4 * n) >> 1)) = hp[ai][gu][3][n];
                        if (ai == 1 && wr == 1) *(u32x2*)(HL + (size_t)(u.pm * 2 + fr - 14) * 11264 + pn * 256 + 128 * gu + colw + 4 * n) = hp[1][gu][3][n]; }
        }
        if (wr == 0 && fr < 2) {
#pragma unroll
            for (int gu = 0; gu < 2; ++gu)
#pragma unroll
                for (int n = 0; n < 2; ++n) *(u32x2*)(HF + (size_t)(u.pm * 2 + fr) * 11264 + pn * 256 + 128 * gu + colw + 4 * n) = hp[0][gu][0][n];
        }
        asm volatile("s_waitcnt vmcnt(0) lgkmcnt(0)" ::: "memory"); __builtin_amdgcn_s_barrier(); asm volatile("" ::: "memory");
#pragma unroll
        for (int ai = 0; ai < 2; ++ai) {
            const bool hasp = (ai == 1) || (wr == 1); const int qp = 2 * ai + wr - 1;
#pragma unroll
            for (int m = 0; m < 4; ++m) {
                f32x4 ov[2];
#pragma unroll
                for (int n = 0; n < 2; ++n) {
                    u32x2 cv[2];
#pragma unroll
                    for (int gu = 0; gu < 2; ++gu) {
                        const PG8_LAS u32x2* cp = (const PG8_LAS u32x2*)(cwl + gu * 256 + ((colw + 4 * n) >> 1));
                        const u32x2 w0 = cp[0], w1 = cp[32], w2 = cp[64], bb = cp[96];
                        const u32x2 hc = hp[ai][gu][m][n];
                        u32x2 o1, o2;
                        if (m > 0) { const u32x2 q = hp[ai][gu][m > 0 ? m - 1 : 0][n]; o1.x = dpp_ror1(q.x); o1.y = dpp_ror1(q.y); o2.x = dpp_ror2(q.x); o2.y = dpp_ror2(q.y); }
                        else if (hasp) { const u32x2 p1 = *(const PG8_LAS u32x2*)(xl + (((qp * 2 + 1) * 256 + 128 * gu + colw + 4 * n) >> 1)), p2 = *(const PG8_LAS u32x2*)(xl + (((qp * 2 + 0) * 256 + 128 * gu + colw + 4 * n) >> 1));
                            o1 = p1; o2.x = fr == 0 ? p2.x : p1.x; o2.y = fr == 0 ? p2.y : p1.y; }
                        else { o1 = (u32x2){0u, 0u}; o2 = o1; }
                        u32x2 s1, s2; s1.x = dpp_shr1(o1.x, hc.x); s1.y = dpp_shr1(o1.y, hc.y); s2.x = dpp_shr2(o2.x, hc.x); s2.y = dpp_shr2(o2.y, hc.y);
                        cv[gu].x = h2_bits(as_h2(w0.x) * as_h2(s2.x) + (as_h2(w1.x) * as_h2(s1.x) + (as_h2(w2.x) * as_h2(hc.x) + as_h2(bb.x))));
                        cv[gu].y = h2_bits(as_h2(w0.y) * as_h2(s2.y) + (as_h2(w1.y) * as_h2(s1.y) + (as_h2(w2.y) * as_h2(hc.y) + as_h2(bb.y))));
                    }
                    const f16x2_t g0 = as_h2(cv[0].x), g1 = as_h2(cv[0].y), p0 = g0 * as_h2(cv[1].x), p1 = g1 * as_h2(cv[1].y);
                    ov[n][0] = (float)p0[0] * __builtin_amdgcn_rcpf(1.0f + __builtin_amdgcn_exp2f((float)g0[0]));
                    ov[n][1] = (float)p0[1] * __builtin_amdgcn_rcpf(1.0f + __builtin_amdgcn_exp2f((float)g0[1]));
                    ov[n][2] = (float)p1[0] * __builtin_amdgcn_rcpf(1.0f + __builtin_amdgcn_exp2f((float)g1[0]));
                    ov[n][3] = (float)p1[1] * __builtin_amdgcn_rcpf(1.0f + __builtin_amdgcn_exp2f((float)g1[1]));
                }
                *(u32x4*)(ACT + (size_t)(row0 + ai * HALF + m * 16) * 5632 + c0) = pack8(ov[0], ov[1]);
            }
        }
    }
};
template <class Epi, class Sched, bool ALIGN_EPI = false, bool SP2 = false>
__device__ __forceinline__ void gemm_phase(PG8_LAS unsigned char* lds, const Gemm g, const Sched& S, const Epi& E, const int tid) {
    const int wid = __builtin_amdgcn_readfirstlane(tid >> 6), lane = tid & 63, wr = wid >> 2, wc = wid & 3, fr = lane & 15, fq = lane >> 4;
    const int K = g.K, nt = K / BK, lda = g.lda;
    unsigned voffA[2], voffB[2];
#pragma unroll
    for (int i = 0; i < 2; ++i) { int R, C; stage_rc(tid * 16 + i * 8192, R, C); const int Rb = Epi::PERM ? ((R & ~31) + perm32(R & 31)) : R;
        voffA[i] = (unsigned)(R * lda + C) * 2u; voffB[i] = (unsigned)(Rb * K + C) * 2u; }
    const size_t kstep = (size_t)(BK * 2);
    const size_t hA = (size_t)HALF * lda * 2, hB = (size_t)HALF * K * 2;
    const size_t tA = 2 * hA, tB = 2 * hB;
    const unsigned ldsw = (unsigned)wid * 1024u;
    const int aoff = lds_byte(wr * 64 + fr, fq * 8), boff = lds_byte(wc * 32 + fr, fq * 8);
#define PG8_SA(b, h) (((b) * 2 + (h)) * HTB)
#define PG8_SB(b, h) ((4 + (b) * 2 + (h)) * HTB)
#define PG8_STAGE(bufoff, gbase, voff) do { _Pragma("unroll") for (int _i = 0; _i < 2; ++_i) \
        __builtin_amdgcn_global_load_lds((const unsigned*)((const char*)(gbase) + (voff)[_i]), (PG8_LAS unsigned*)(lds + (bufoff) + ldsw + _i * 8192), 16, 0, 0); } while (0)
#define PG8_LDA(dst, b, h) do { _Pragma("unroll") for (int m = 0; m < 4; ++m) _Pragma("unroll") for (int k = 0; k < 2; ++k) dst[m][k] = *(const PG8_LAS bf16x8*)(lds + PG8_SA(b, h) + aoff + m * 2048 + k * 1024); } while (0)
#define PG8_LDB(dst, b, h) do { _Pragma("unroll") for (int n = 0; n < 2; ++n) _Pragma("unroll") for (int k = 0; k < 2; ++k) dst[n][k] = *(const PG8_LAS bf16x8*)(lds + PG8_SB(b, h) + boff + n * 2048 + k * 1024); } while (0)
#define PG8_MMA(ai, bj, At, Bt) do { __builtin_amdgcn_s_setprio(1); _Pragma("unroll") for (int m = 0; m < 4; ++m) _Pragma("unroll") for (int n = 0; n < 2; ++n) _Pragma("unroll") for (int k = 0; k < 2; ++k) \
        acc[ai][bj][m][n] = __builtin_amdgcn_mfma_f32_16x16x32_bf16(Bt[n][k], At[m][k], acc[ai][bj][m][n], 0, 0, 0); __builtin_amdgcn_s_setprio(0); } while (0)
#define PG8_WAIT_V(n) asm volatile("s_waitcnt vmcnt(" #n ")" ::: "memory")
#define PG8_WAIT_L(n) asm volatile("s_waitcnt lgkmcnt(" #n ")" ::: "memory")
#define PG8_BAR __builtin_amdgcn_s_barrier()
#define PG8_SCHED __builtin_amdgcn_sched_barrier(0)
    Unit cur, nxt; int ui = 0;
    if (!S.next(0, cur)) return;
    f32x4 acc[2][2][4][2];
#pragma unroll
    for (int a = 0; a < 2; ++a)
#pragma unroll
        for (int b = 0; b < 2; ++b)
#pragma unroll
            for (int m = 0; m < 4; ++m)
#pragma unroll
                for (int n = 0; n < 2; ++n) acc[a][b][m][n] = (f32x4){0.f, 0.f, 0.f, 0.f};
    bf16x8 At[4][2], B0[2][2], B1[2][2];
    const char* cA = (const char*)(cur.seg ? g.A1 : g.A) + (size_t)cur.pm * tA; const char* cB = (const char*)(cur.seg ? g.Bt1 : g.Bt) + (size_t)cur.pn * tB;
    S.a_ready(cur);
    if constexpr (SP2) {
        PG8_STAGE(PG8_SB(0, 0), cB, voffB); PG8_STAGE(PG8_SB(0, 1), cB + hB, voffB); PG8_STAGE(PG8_SA(0, 0), cA, voffA); PG8_STAGE(PG8_SA(0, 1), cA + hA, voffA);
        if (wr == 1) PG8_BAR;
        PG8_WAIT_V(2); PG8_BAR;
        PG8_STAGE(PG8_SB(1, 0), cB + kstep, voffB); PG8_STAGE(PG8_SA(1, 0), cA + kstep, voffA); PG8_STAGE(PG8_SB(1, 1), cB + hB + kstep, voffB);
        PG8_WAIT_V(6); PG8_BAR;
    } else {
        PG8_STAGE(PG8_SB(0, 0), cB, voffB); PG8_STAGE(PG8_SA(0, 0), cA, voffA); PG8_STAGE(PG8_SB(0, 1), cB + hB, voffB); PG8_STAGE(PG8_SA(0, 1), cA + hA, voffA);
        if (wr == 1) PG8_BAR;
        PG8_WAIT_V(4); PG8_BAR;
        PG8_STAGE(PG8_SB(1, 0), cB + kstep, voffB); PG8_STAGE(PG8_SA(1, 0), cA + kstep, voffA); PG8_STAGE(PG8_SB(1, 1), cB + hB + kstep, voffB);
        PG8_WAIT_V(6); PG8_BAR;
    }
    for (;;) {
        const bool has_next = S.next(ui + 1, nxt);
        const char* nA = has_next ? (const char*)(nxt.seg ? g.A1 : g.A) + (size_t)nxt.pm * tA : cA; const char* nB = has_next ? (const char*)(nxt.seg ? g.Bt1 : g.Bt) + (size_t)nxt.pn * tB : cB;
        for (int t = 0; t < nt; t += 2) {
            const bool last = (t == nt - 2);
            const char* a1 = cA + (size_t)(t + 1) * kstep;
            const char* a2 = last ? nA : cA + (size_t)(t + 2) * kstep; const char* b2 = last ? nB : cB + (size_t)(t + 2) * kstep;
            const char* a3 = a2 + kstep; const char* b3 = b2 + kstep;
            if (last && has_next) S.a_ready(nxt);
            if constexpr (SP2) {
            PG8_LDB(B0, 0, 0); PG8_LDB(B1, 0, 1); PG8_SCHED; PG8_LDA(At, 0, 0); PG8_STAGE(PG8_SA(1, 1), a1 + hA, voffA);
            PG8_WAIT_V(8); PG8_WAIT_L(0); PG8_BAR; PG8_MMA(0, 0, At, B0); PG8_MMA(0, 1, At, B1); PG8_BAR; PG8_SCHED;
            PG8_LDA(At, 0, 1); PG8_STAGE(PG8_SB(0, 0), b2, voffB); PG8_STAGE(PG8_SB(0, 1), b2 + hB, voffB); PG8_STAGE(PG8_SA(0, 0), a2, voffA);
            PG8_WAIT_V(8); PG8_WAIT_L(0); PG8_BAR; PG8_MMA(1, 0, At, B0); PG8_MMA(1, 1, At, B1); PG8_BAR; PG8_SCHED;
            PG8_LDB(B0, 1, 0); PG8_LDB(B1, 1, 1); PG8_SCHED; PG8_LDA(At, 1, 0); PG8_STAGE(PG8_SA(0, 1), a2 + hA, voffA);
            PG8_WAIT_V(8); PG8_WAIT_L(0); PG8_BAR; PG8_MMA(0, 0, At, B0); PG8_MMA(0, 1, At, B1); PG8_BAR; PG8_SCHED;
            PG8_LDA(At, 1, 1); PG8_STAGE(PG8_SB(1, 0), b3, voffB); PG8_STAGE(PG8_SB(1, 1), b3 + hB, voffB); PG8_STAGE(PG8_SA(1, 0), a3, voffA);
            PG8_WAIT_V(8); PG8_WAIT_L(0); PG8_BAR; PG8_MMA(1, 0, At, B0); PG8_MMA(1, 1, At, B1); PG8_BAR; PG8_SCHED;
            } else {
            PG8_LDB(B0, 0, 0); PG8_SCHED; PG8_LDA(At, 0, 0); PG8_STAGE(PG8_SA(1, 1), a1 + hA, voffA);
            PG8_WAIT_L(8); PG8_BAR; PG8_WAIT_L(0); PG8_MMA(0, 0, At, B0); PG8_BAR; PG8_SCHED;
            PG8_LDB(B1, 0, 1); PG8_STAGE(PG8_SB(0, 0), b2, voffB);
            PG8_BAR; PG8_WAIT_L(0); PG8_MMA(0, 1, At, B1); PG8_BAR;
            PG8_LDA(At, 0, 1); PG8_STAGE(PG8_SA(0, 0), a2, voffA);
            PG8_BAR; PG8_WAIT_L(0); PG8_MMA(1, 0, At, B0); PG8_BAR; PG8_SCHED;
            PG8_STAGE(PG8_SB(0, 1), b2 + hB, voffB);
            PG8_WAIT_V(6); PG8_BAR; PG8_MMA(1, 1, At, B1); PG8_BAR;
            PG8_LDB(B0, 1, 0); PG8_SCHED; PG8_LDA(At, 1, 0); PG8_STAGE(PG8_SA(0, 1), a2 + hA, voffA);
            PG8_WAIT_L(8); PG8_BAR; PG8_WAIT_L(0); PG8_MMA(0, 0, At, B0); PG8_BAR; PG8_SCHED;
            PG8_LDB(B1, 1, 1); PG8_STAGE(PG8_SB(1, 0), b3, voffB);
            PG8_BAR; PG8_WAIT_L(0); PG8_MMA(0, 1, At, B1); PG8_BAR;
            PG8_LDA(At, 1, 1); PG8_STAGE(PG8_SA(1, 0), a3, voffA);
            PG8_BAR; PG8_WAIT_L(0); PG8_MMA(1, 0, At, B0); PG8_BAR; PG8_SCHED;
            PG8_STAGE(PG8_SB(1, 1), b3 + hB, voffB);
            PG8_WAIT_V(6); PG8_BAR; PG8_MMA(1, 1, At, B1); PG8_BAR;
            }
        }
        if constexpr (ALIGN_EPI) { if (wr == 0) PG8_BAR; }
        if constexpr (!Epi::AFTER_DRAIN) { E(acc, cur, wr, wc, fr, fq); S.done(cur); }
        if (!has_next) break;
        if (!Epi::keeps_acc(cur)) {
#pragma unroll
        for (int a = 0; a < 2; ++a)
#pragma unroll
            for (int b = 0; b < 2; ++b)
#pragma unroll
                for (int m = 0; m < 4; ++m)
#pragma unroll
                    for (int n = 0; n < 2; ++n) acc[a][b][m][n] = (f32x4){0.f, 0.f, 0.f, 0.f};
        }
        cur = nxt; cA = nA; cB = nB; ++ui;
        if constexpr (ALIGN_EPI) { if (wr == 1) PG8_BAR; }
    }
    PG8_WAIT_V(0);
    if constexpr (!ALIGN_EPI) { if (wr == 0) PG8_BAR; }
    PG8_BAR;
    if constexpr (Epi::AFTER_DRAIN) { E.fused(acc, cur, wr, wc, fr, fq, lds, wid, lane); S.done(cur); }
#undef PG8_SA
#undef PG8_SB
#undef PG8_STAGE
#undef PG8_LDA
#undef PG8_LDB
#undef PG8_MMA
#undef PG8_WAIT_V
#undef PG8_WAIT_L
#undef PG8_BAR
#undef PG8_SCHED
}
}
#define GAS __attribute__((address_space(1)))
#define LAS __attribute__((address_space(3)))
typedef unsigned short bf16;
typedef unsigned v4u __attribute__((ext_vector_type(4)));
typedef float f32x4 __attribute__((ext_vector_type(4)));
typedef short bf16x8 __attribute__((ext_vector_type(8)));
typedef GAS unsigned gu32;
typedef GAS unsigned long long gu64;
#define RLX_AGENT __ATOMIC_RELAXED, __HIP_MEMORY_SCOPE_AGENT
#define LDS_WAIT() asm volatile("s_waitcnt lgkmcnt(0)" ::: "memory")
#define VM_WAIT() asm volatile("s_waitcnt vmcnt(0)" ::: "memory")
__device__ __forceinline__ unsigned long long rt() { return __builtin_amdgcn_s_memrealtime(); }
__device__ __forceinline__ unsigned f2bf(float f) { unsigned u = __builtin_bit_cast(unsigned, f); return (u + 0x7fffu + ((u >> 16) & 1u)) >> 16; }
__device__ __forceinline__ unsigned pk2(float lo, float hi) { return f2bf(lo) | (f2bf(hi) << 16); }

#define XB_TMO      128
#define XB_XCNT(j)  (256  + 64 * (j))
#define XB_XSUB(j)  (1280 + 64 * (j))
#define XB_XGEN(j)  (2304 + 64 * (j))
#define XB_TOP      3328
#define XB_TOPGEN   3392
#define XCD_BAR_WORDS 3456
#define XB_SPIN_CAP (1u << 18)

__device__ __forceinline__ unsigned xb_ld(unsigned* p)              { return __hip_atomic_load(p, __ATOMIC_RELAXED, __HIP_MEMORY_SCOPE_AGENT); }
__device__ __forceinline__ unsigned xb_add(unsigned* p, unsigned v) { return __hip_atomic_fetch_add(p, v, __ATOMIC_RELAXED, __HIP_MEMORY_SCOPE_AGENT); }
__device__ __forceinline__ unsigned xb_xcc_id() { return (unsigned)__builtin_amdgcn_s_getreg((3 << 11) | 20) & 0xFu; }
#define XB_SPIN(cond, bar) do { unsigned _sp = 0; while (cond) { __builtin_amdgcn_s_sleep(1); \
    if ((++_sp & 255u) == 0u) { if (xb_ld(&(bar)[XB_TMO])) break; if (_sp > XB_SPIN_CAP) { atomicAdd(&(bar)[XB_TMO], 1u); break; } } } } while (0)

struct XcdBarrier {
    unsigned* bar; unsigned x;
    volatile LAS unsigned* st;
};

__device__ __forceinline__ XcdBarrier xcd_barrier_post(unsigned* bar, volatile LAS unsigned* st) {
    XcdBarrier b; b.bar = bar; b.x = xb_xcc_id(); b.st = st;
    if (threadIdx.x == 0) (void)xb_add(&bar[XB_XCNT(b.x)], 1u);
    return b;
}
__device__ __forceinline__ void xcd_barrier_complete(unsigned* bar, unsigned x, unsigned& nloc, unsigned& nx) {
    const unsigned G = gridDim.x * gridDim.y * gridDim.z;
    unsigned sum, cnt, mine, sp = 0u;
    for (;;) {
        sum = 0u; cnt = 0u; mine = 0u;
#pragma unroll
        for (unsigned j = 0; j < 16; ++j) { const unsigned c = xb_ld(&bar[XB_XCNT(j)]); sum += c; cnt += (c > 0u) ? 1u : 0u; mine = (j == x) ? c : mine; }
        if (sum == G) break;
        __builtin_amdgcn_s_sleep(1);
        if ((++sp & 255u) == 0u) { if (xb_ld(&bar[XB_TMO])) break; if (sp > XB_SPIN_CAP) { atomicAdd(&bar[XB_TMO], 1u); break; } }
    }
    nloc = mine > 0u ? mine : 1u; nx = cnt > 0u ? cnt : 1u;
}

__device__ __forceinline__ void xcd_barrier(const XcdBarrier& b) {
    asm volatile("s_waitcnt vmcnt(0)" ::: "memory");
    __syncthreads();
    if (threadIdx.x == 0) {
        unsigned* bar = b.bar;
        __builtin_amdgcn_s_waitcnt(0);
        unsigned nloc = b.st[0], nx = b.st[1];
        if (nloc == 0u) { xcd_barrier_complete(bar, b.x, nloc, nx); b.st[0] = nloc; b.st[1] = nx; }
        const unsigned old = xb_add(&bar[XB_XSUB(b.x)], 1u);
        const unsigned gen = old / nloc;
        if (old + 1u == (gen + 1u) * nloc) {
            __builtin_amdgcn_fence(__ATOMIC_RELEASE, "agent");
            asm volatile("s_waitcnt vmcnt(0)" ::: "memory");
            const unsigned og = xb_add(&bar[XB_TOP], 1u);
            const unsigned tg = og / nx;
            if (og + 1u == (tg + 1u) * nx) xb_add(&bar[XB_TOPGEN], 1u);
            else XB_SPIN(xb_ld(&bar[XB_TOPGEN]) == tg, bar);
            __builtin_amdgcn_fence(__ATOMIC_ACQUIRE, "agent");
            xb_add(&bar[XB_XGEN(b.x)], 1u);
            asm volatile("s_waitcnt vmcnt(0)" ::: "memory");
        } else {
            XB_SPIN(xb_ld(&bar[XB_XGEN(b.x)]) == gen, bar);
            __builtin_amdgcn_fence(__ATOMIC_ACQUIRE, "agent");
            asm volatile("s_waitcnt vmcnt(0)" ::: "memory");
        }
    }
    __syncthreads();
}
typedef unsigned v2u __attribute__((ext_vector_type(2)));
typedef float v2f __attribute__((ext_vector_type(2)));

constexpr int NWAVES = 8;
constexpr int M = 16384, DM = 2048, SEQ = 2048, DFF = 5632, NH = 11264, WIN_LD = 8720;
using pg8::NZ; using pg8::ZQA; using pg8::ZKA; using pg8::ZVA; using pg8::ZQB; using pg8::ZKB; using pg8::ZVB; using pg8::ZRB; using pg8::ZAL; using pg8::ZGA; using pg8::ZGB;
constexpr int N_PHASES = 19;
constexpr size_t MiB = 1u << 20;
constexpr size_t WS_CTL = 0, CTL_ZERO_BYTES = 1 * MiB;
constexpr size_t WS_SSQ = 1 * MiB;
constexpr size_t WS_ROPE = 3 * MiB;
constexpr size_t WS_ONES = 4 * MiB;
constexpr size_t WS_WUP = 8 * MiB;
constexpr size_t WS_WDN = 52 * MiB;
constexpr size_t WS_XB = 74 * MiB;
constexpr size_t WS_WIN = 138 * MiB;
constexpr size_t WS_WA = 174 * MiB, WS_WB = 178 * MiB;
constexpr size_t WS_WO = 182 * MiB;
constexpr size_t WS_ZB = 190 * MiB;
constexpr size_t WS_LA = 478 * MiB;
constexpr size_t WS_Y = 510 * MiB;
constexpr size_t WS_MIX = 574 * MiB;
constexpr size_t WS_HF = 190 * MiB, WS_HL = 198 * MiB;
constexpr size_t WS_ACT = 490 * MiB;
constexpr size_t WS_END = 666 * MiB;
static_assert(WS_HL + (size_t)64 * 2 * NH * 4 <= WS_ACT && WS_ACT + (size_t)M * DFF * 2 <= WS_END && WS_MIX + (size_t)M * DM * 2 <= WS_END && WS_ZB + (size_t)M * NZ * 2 <= WS_LA, "ws map");
constexpr int CW_BAR = 4096;
constexpr int RING_OFF = 0, RING_BYTES = 131072;
constexpr int LDSCTL_OFF = RING_BYTES, MISC_OFF = LDSCTL_OFF + 320;
constexpr int RSTAB_OFF = LDSCTL_OFF + 1024;
constexpr int XL_OFF = RSTAB_OFF + 8192;
constexpr int CWL_OFF = XL_OFF + 8192;
constexpr int LDS_BYTES = 163840;
static_assert(CWL_OFF + 4096 <= LDS_BYTES, "LDS map");

__device__ __forceinline__ float wave_sum(float v) {
#pragma unroll
    for (int o = 1; o < 64; o <<= 1) v += __shfl_xor(v, o);
    return v;
}
__device__ __forceinline__ float wave_max(float v) {
#pragma unroll
    for (int o = 1; o < 64; o <<= 1) v = fmaxf(v, __shfl_xor(v, o));
    return v;
}
__device__ __forceinline__ float bf2f(bf16 b) { return __uint_as_float(((unsigned)b) << 16); }
__device__ __forceinline__ float bflo(unsigned w) { return __uint_as_float(w << 16); }
__device__ __forceinline__ float bfhi(unsigned w) { return __uint_as_float(w & 0xffff0000u); }
__device__ __forceinline__ void un8h(v4u w, float (&f)[8]) { const pg8::f16x2_t a = pg8::as_h2(w.x), b = pg8::as_h2(w.y), c = pg8::as_h2(w.z), d = pg8::as_h2(w.w); f[0] = (float)a[0]; f[1] = (float)a[1]; f[2] = (float)b[0]; f[3] = (float)b[1]; f[4] = (float)c[0]; f[5] = (float)c[1]; f[6] = (float)d[0]; f[7] = (float)d[1]; }
__device__ __forceinline__ void un8(v4u w, float (&f)[8]) { f[0] = bflo(w.x); f[1] = bfhi(w.x); f[2] = bflo(w.y); f[3] = bfhi(w.y); f[4] = bflo(w.z); f[5] = bfhi(w.z); f[6] = bflo(w.w); f[7] = bfhi(w.w); }
using pg8::cvt_pk_bf16;
__device__ const double ROPE_INVF[8] = {1.0, 0.19392274474868576, 0.03760603093086393, 0.007292664737217109, 0.001414213562373095, 0.0002742481756762073, 5.318295896944988e-05, 1.031338537721246e-05};

__device__ __forceinline__ void alpha_item(const float* Win, const float* Wau, const float* gk, int k0, int j0, bf16* WT, LAS float* scr, int lane) {
    const int jj = lane & 31;
    float wa[16];
#pragma unroll
    for (int r = 0; r < 16; ++r) wa[r] = Wau[r * 512 + j0 + jj];
#pragma unroll 4
    for (int i = 0; i < 32; ++i) { const int kk = 2 * i + (lane >> 5); const float* wr = Win + (size_t)(k0 + kk) * WIN_LD + 4608; float s = 0.f;
#pragma unroll
        for (int r = 0; r < 16; ++r) s += wr[r] * wa[r];
        scr[kk * 33 + jj] = s * gk[k0 + kk]; }
    LDS_WAIT(); asm volatile("" ::: "memory");
    const int c = lane & 7;
#pragma unroll
    for (int j = 0; j < 4; ++j) { const int n = (lane >> 3) + 8 * j; const LAS float* s = scr + (8 * c) * 33 + n;
        v4u o; o.x = cvt_pk_bf16(s[0 * 33], s[1 * 33]); o.y = cvt_pk_bf16(s[2 * 33], s[3 * 33]); o.z = cvt_pk_bf16(s[4 * 33], s[5 * 33]); o.w = cvt_pk_bf16(s[6 * 33], s[7 * 33]);
        *(GAS v4u*)(WT + (size_t)(ZAL + j0 + n) * DM + k0 + 8 * c) = o; }
    LDS_WAIT(); asm volatile("" ::: "memory");
}


__device__ __forceinline__ void fill_rstd_table(const float* ssq, LAS unsigned char* lds, int tid) {
    const int base = 2048 * ((int)blockIdx.x & 7);
#pragma unroll
    for (int i = 0; i < 4; ++i) { const int r = tid + 512 * i; const GAS f32x4* p = (const GAS f32x4*)(ssq + (size_t)(base + r) * 32);
        f32x4 a = p[0];
#pragma unroll
        for (int q = 1; q < 8; ++q) a = a + p[q];
        ((LAS float*)(lds + RSTAB_OFF))[r] = 1.0f / sqrtf(((a[0] + a[1]) + (a[2] + a[3])) * (1.0f / 2048.0f) + pg8::RMS_EPS); }
    __syncthreads();
}

struct Args { const void* in[17]; float* out; unsigned char* ws; int ph_lo, ph_hi; };
typedef const __attribute__((address_space(4))) Args* ArgsK;
struct LayerIn { const float *gmix, *win, *sink, *wau, *balpha, *ggla, *wa, *wb, *wo, *gffn, *wup, *cw, *cb, *wdn; };

struct TItem { const float* src; const float* gk; bf16* dst; int ldw, ldt; };
constexpr int I_IN = 272 * 32, I_A = 64 * 16, I_O = 64 * 32, I_UP = 352 * 32, I_DN = 64 * 88, I_AL = 16 * 32;
constexpr int NS_ITEMS = 2 * I_A + I_O + I_UP + I_DN;
__device__ __forceinline__ TItem decode_win(const float* win, const float* gmix, unsigned char* ws, int r) {
    TItem t; const int kb = r / 272, nb = r % 272; const int n0 = nb < 144 ? nb * 32 : 5120 + (nb - 144) * 32; const int c0 = n0 < 4608 ? n0 : n0 - 496;
    t.src = win + (size_t)(kb * 64) * WIN_LD + c0; t.gk = gmix + kb * 64; t.dst = (bf16*)(ws + WS_WIN) + (size_t)n0 * DM + kb * 64; t.ldw = WIN_LD; t.ldt = DM; return t;
}
__device__ __forceinline__ TItem decode_side(const LayerIn& L, unsigned char* ws, int it) {
    TItem t; int r = it;
    if (r < I_A) { const int kb = r / 64, nb = r % 64; t.src = L.wa + (size_t)(kb * 64) * DM + nb * 32; t.gk = nullptr; t.dst = (bf16*)(ws + WS_WA) + (size_t)(nb * 32) * 1024 + kb * 64; t.ldw = DM; t.ldt = 1024; return t; } r -= I_A;
    if (r < I_A) { const int kb = r / 64, nb = r % 64; t.src = L.wb + (size_t)(kb * 64) * DM + nb * 32; t.gk = nullptr; t.dst = (bf16*)(ws + WS_WB) + (size_t)(nb * 32) * 1024 + kb * 64; t.ldw = DM; t.ldt = 1024; return t; } r -= I_A;
    if (r < I_O) { const int kb = r / 64, nb = r % 64; t.src = L.wo + (size_t)(kb * 64) * DM + nb * 32; t.gk = nullptr; t.dst = (bf16*)(ws + WS_WO) + (size_t)(nb * 32) * DM + kb * 64; t.ldw = DM; t.ldt = DM; return t; } r -= I_O;
    if (r < I_UP) { const int kb = r / 352, nb = r % 352; const int n0 = nb * 32, pn = n0 >> 8, j0 = n0 & 255; const int c0 = j0 < 128 ? 128 * pn + j0 : DFF + 128 * pn + (j0 - 128);
        t.src = L.wup + (size_t)(kb * 64) * NH + c0; t.gk = L.gffn + kb * 64; t.dst = (bf16*)(ws + WS_WUP) + (size_t)n0 * DM + kb * 64; t.ldw = NH; t.ldt = DM; return t; } r -= I_UP;
    { const int kb = r / 64, nb = r % 64; t.src = L.wdn + (size_t)(kb * 64) * DM + nb * 32; t.gk = nullptr; t.dst = (bf16*)(ws + WS_WDN) + (size_t)(nb * 32) * DFF + kb * 64; t.ldw = DM; t.ldt = DFF; return t; }
}
struct SideJob { ArgsK ap; int l; };
__device__ __forceinline__ TItem decode_job(const SideJob& J, unsigned char* ws, int it) {
    const int l = J.l;
    if (it >= NS_ITEMS) return decode_win((const float*)J.ap->in[3] + (size_t)DM * WIN_LD, (const float*)J.ap->in[2] + DM, ws, it - NS_ITEMS);
    LayerIn L;
    L.wa = (const float*)J.ap->in[8] + (size_t)l * 1024 * DM; L.wb = (const float*)J.ap->in[9] + (size_t)l * 1024 * DM; L.wo = (const float*)J.ap->in[10] + (size_t)l * DM * DM;
    L.gffn = (const float*)J.ap->in[11] + (size_t)l * DM; L.wup = (const float*)J.ap->in[12] + (size_t)l * DM * NH; L.wdn = (const float*)J.ap->in[15] + (size_t)l * DFF * DM;
    return decode_side(L, ws, it);
}
__device__ __forceinline__ void titem_load(const TItem& t, int lane, float (&v)[32], f32x4 (&g)[2]) {
    const float* p = t.src + (size_t)(lane >> 5) * t.ldw + (lane & 31);
#pragma unroll
    for (int i = 0; i < 32; ++i) v[i] = p[(size_t)(2 * i) * t.ldw];
    if (t.gk) { g[0] = *(const GAS f32x4*)(t.gk + 8 * (lane & 7)); g[1] = *(const GAS f32x4*)(t.gk + 8 * (lane & 7) + 4); }
    else { g[0] = (f32x4){1.f, 1.f, 1.f, 1.f}; g[1] = g[0]; }
}
__device__ __forceinline__ void titem_store(const TItem& t, int lane, const float (&v)[32], const f32x4 (&g)[2], LAS float* scr) {
#pragma unroll
    for (int i = 0; i < 32; ++i) scr[(2 * i + (lane >> 5)) * 33 + (lane & 31)] = v[i];
    LDS_WAIT(); asm volatile("" ::: "memory");
    const int c = lane & 7;
#pragma unroll
    for (int j = 0; j < 4; ++j) { const int n = (lane >> 3) + 8 * j; const LAS float* s = scr + (8 * c) * 33 + n;
        v4u o; o.x = cvt_pk_bf16(s[0 * 33] * g[0][0], s[1 * 33] * g[0][1]); o.y = cvt_pk_bf16(s[2 * 33] * g[0][2], s[3 * 33] * g[0][3]); o.z = cvt_pk_bf16(s[4 * 33] * g[1][0], s[5 * 33] * g[1][1]); o.w = cvt_pk_bf16(s[6 * 33] * g[1][2], s[7 * 33] * g[1][3]);
        *(GAS v4u*)(t.dst + (size_t)n * t.ldt + 8 * c) = o; }
    LDS_WAIT(); asm volatile("" ::: "memory");
}
__device__ __forceinline__ void phase_weights(const LayerIn& L, unsigned char* ws, LAS unsigned char* lds, int gw, int NGW, int wave, int lane) {
    LAS float* scr = (LAS float*)(lds + RING_OFF + wave * 16384);
    float vA[32], vB[32]; f32x4 gA[2], gB[2]; TItem dA, dB;
    int it = gw;
    if (it < I_IN) { dA = decode_win(L.win, L.gmix, ws, it); titem_load(dA, lane, vA, gA); }
    while (it < I_IN) {
        const int it2 = it + NGW, it3 = it2 + NGW;
        if (it2 < I_IN) { dB = decode_win(L.win, L.gmix, ws, it2); titem_load(dB, lane, vB, gB); }
        titem_store(dA, lane, vA, gA, scr);
        if (it3 < I_IN) { dA = decode_win(L.win, L.gmix, ws, it3); titem_load(dA, lane, vA, gA); }
        if (it2 < I_IN) titem_store(dB, lane, vB, gB, scr);
        it = it3;
    }
    for (int r = gw; r < I_AL; r += NGW) { const int kb = r / 16, jb = r % 16; alpha_item(L.win, L.wau, L.gmix, kb * 64, jb * 32, (bf16*)(ws + WS_WIN), scr, lane); }
}
__device__ __forceinline__ void phase_xprep(const float* x, const int* pos, unsigned char* ws, int gw, int NGW, int lane) {
    bf16* XB = (bf16*)(ws + WS_XB); float* SSQ = (float*)(ws + WS_SSQ); float* CS = (float*)(ws + WS_ROPE);
    if (gw == 0) ((float*)(ws + WS_ONES))[lane] = 1.0f;
    for (int m0 = gw * 2; m0 < M; m0 += NGW * 2) {
        f32x4 v[2][8]; float s[2] = {0.f, 0.f};
#pragma unroll
        for (int k = 0; k < 2; ++k) { const GAS f32x4* xr = (const GAS f32x4*)(x + (size_t)(m0 + k) * DM) + lane;
#pragma unroll
            for (int j = 0; j < 8; ++j) { v[k][j] = xr[64 * j]; s[k] += (v[k][j].x * v[k][j].x + v[k][j].y * v[k][j].y) + (v[k][j].z * v[k][j].z + v[k][j].w * v[k][j].w); } }
#pragma unroll
        for (int off = 1; off < 64; off <<= 1) { s[0] += __shfl_xor(s[0], off); s[1] += __shfl_xor(s[1], off); }
#pragma unroll
        for (int k = 0; k < 2; ++k) { const int m = m0 + k;
            GAS v2u* o8 = (GAS v2u*)(XB + (size_t)m * DM) + lane;
#pragma unroll
            for (int j = 0; j < 8; ++j) { v2u w; w.x = cvt_pk_bf16(v[k][j].x, v[k][j].y); w.y = cvt_pk_bf16(v[k][j].z, v[k][j].w); o8[64 * j] = w; }
            if (lane < 32) SSQ[(size_t)m * 32 + lane] = lane == 0 ? s[k] : 0.f;
            if (lane < 8) {
                const double a = (double)pos[m] * ROPE_INVF[lane] * 0.15915494309189535; const float fr = (float)(a - rint(a));
                v2f cs2; cs2.x = __builtin_amdgcn_cosf(fr); cs2.y = __builtin_amdgcn_sinf(fr); *(GAS v2f*)(CS + (size_t)m * 16 + 2 * lane) = cs2; } }
    }
}

typedef float f32x16 __attribute__((ext_vector_type(16)));
typedef short s16x4 __attribute__((ext_vector_type(4)));
constexpr int SW_PITCH = 144, SW_KOFF = 0, SW_VOFF = 256 * SW_PITCH;
__device__ __forceinline__ s16x4 lds_tr(LAS const unsigned char* p) { return __builtin_bit_cast(s16x4, __builtin_amdgcn_ds_read_tr16_b64_v4i16((LAS s16x4*)p)); }
__device__ __forceinline__ bf16x8 mk8(s16x4 lo, s16x4 hi) { return (bf16x8){lo[0], lo[1], lo[2], lo[3], hi[0], hi[1], hi[2], hi[3]}; }
__device__ __forceinline__ void swa_phase(const bf16* Z, const float* sink, bf16* Y, LAS unsigned char* lds, int tid0, int G) {
    const int wave = __builtin_amdgcn_readfirstlane(tid0 >> 6);
    for (int it = blockIdx.x; it < 512; it += G) {
        int tid = tid0; asm volatile("" : "+v"(tid));
        const int lane = tid & 63, r32 = lane & 31, hh = lane >> 5;
        const int tq = (lane & 15) >> 2, tp = lane & 3, tcb = 16 * ((lane >> 4) & 1);
        const int b = it >> 6, blk = (it >> 2) & 15, hk = it & 3;
        const int r0 = b * SEQ + blk * 128 - 128;
        v4u kv[4], vv[4];
#pragma unroll
        for (int i = 0; i < 4; ++i) { const int c = tid + 512 * i, ki = c >> 3, dc = c & 7;
            if (blk > 0 || ki >= 128) { const bf16* src = Z + (size_t)(r0 + ki) * NZ + hk * 64 + dc * 8; kv[i] = *(const GAS v4u*)(src + ZKA); vv[i] = *(const GAS v4u*)(src + ZVA); }
            else { kv[i] = (v4u){0u, 0u, 0u, 0u}; vv[i] = (v4u){0u, 0u, 0u, 0u}; } }
#pragma unroll
        for (int i = 0; i < 4; ++i) { const int c = tid + 512 * i, ki = c >> 3, dc = c & 7;
            *(LAS v4u*)(lds + SW_KOFF + ki * SW_PITCH + dc * 16) = kv[i]; *(LAS v4u*)(lds + SW_VOFF + ki * SW_PITCH + dc * 16) = vv[i]; }
        __syncthreads();
        const int hq = 4 * hk + (wave >> 1);
        const float sk = sink[hq] * pg8::LOG2E;
#pragma nounroll
        for (int qs = 0; qs < 2; ++qs) {
            const int a = 2 * (wave & 1) + qs, q0 = 32 * a;
            const size_t rowq = (size_t)b * SEQ + blk * 128 + q0 + r32;
            bf16x8 qf[4];
#pragma unroll
            for (int s = 0; s < 4; ++s) qf[s] = *(const GAS bf16x8*)(Z + rowq * NZ + ZQA + hq * 64 + 16 * s + 8 * hh);
            f32x16 sc[5];
#pragma unroll
            for (int j = 0; j < 5; ++j) {
                f32x16 acc = {0.f, 0.f, 0.f, 0.f, 0.f, 0.f, 0.f, 0.f, 0.f, 0.f, 0.f, 0.f, 0.f, 0.f, 0.f, 0.f};
                const LAS unsigned char* kp = lds + SW_KOFF + (32 * (a + j) + r32) * SW_PITCH + 16 * hh;
#pragma unroll
                for (int s = 0; s < 4; ++s) acc = __builtin_amdgcn_mfma_f32_32x32x16_bf16(*(const LAS bf16x8*)(kp + 32 * s), qf[s], acc, 0, 0, 0);
                sc[j] = acc;
            }
            const int qi = q0 + r32;
            float mx = -INFINITY;
#pragma unroll
            for (int j = 0; j < 5; ++j)
#pragma unroll
                for (int rho = 0; rho < 16; ++rho) { const int key = 32 * (a + j) + (rho & 3) + 8 * (rho >> 2) + 4 * hh;
                    const bool ok = (key > qi) && (key <= qi + 128) && (blk > 0 || key >= 128);
                    const float v = ok ? sc[j][rho] : -INFINITY; sc[j][rho] = v; mx = fmaxf(mx, v); }
            mx = fmaxf(mx, __shfl_xor(mx, 32)); mx = fmaxf(mx, sk);
            float ls = 0.f;
#pragma unroll
            for (int j = 0; j < 5; ++j)
#pragma unroll
                for (int rho = 0; rho < 16; ++rho) { const float p = __builtin_amdgcn_exp2f(sc[j][rho] - mx); sc[j][rho] = p; ls += p; }
            ls += __shfl_xor(ls, 32); ls += __builtin_amdgcn_exp2f(sk - mx);
            const float rinv = 1.0f / ls;
            f32x16 oa[2];
            oa[0] = (f32x16){0.f, 0.f, 0.f, 0.f, 0.f, 0.f, 0.f, 0.f, 0.f, 0.f, 0.f, 0.f, 0.f, 0.f, 0.f, 0.f}; oa[1] = oa[0];
#pragma unroll
            for (int j = 0; j < 5; ++j)
#pragma unroll
                for (int s2 = 0; s2 < 2; ++s2) {
                    v4u pw; pw.x = cvt_pk_bf16(sc[j][8 * s2 + 0], sc[j][8 * s2 + 1]); pw.y = cvt_pk_bf16(sc[j][8 * s2 + 2], sc[j][8 * s2 + 3]); pw.z = cvt_pk_bf16(sc[j][8 * s2 + 4], sc[j][8 * s2 + 5]); pw.w = cvt_pk_bf16(sc[j][8 * s2 + 6], sc[j][8 * s2 + 7]);
                    const bf16x8 pf = __builtin_bit_cast(bf16x8, pw);
                    const LAS unsigned char* vp = lds + SW_VOFF + (32 * (a + j) + 16 * s2 + 4 * hh + tq) * SW_PITCH + (tcb + 4 * tp) * 2;
#pragma unroll
                    for (int dt = 0; dt < 2; ++dt) { const bf16x8 vf = mk8(lds_tr(vp + dt * 64), lds_tr(vp + dt * 64 + 8 * SW_PITCH));
                        oa[dt] = __builtin_amdgcn_mfma_f32_32x32x16_bf16(vf, pf, oa[dt], 0, 0, 0); }
                }
            bf16* yp = Y + rowq * DM + hq * 64 + 4 * hh;
#pragma unroll
            for (int dt = 0; dt < 2; ++dt)
#pragma unroll
                for (int gq = 0; gq < 4; ++gq) { v2u w; w.x = cvt_pk_bf16(oa[dt][4 * gq] * rinv, oa[dt][4 * gq + 1] * rinv); w.y = cvt_pk_bf16(oa[dt][4 * gq + 2] * rinv, oa[dt][4 * gq + 3] * rinv);
                    *(GAS v2u*)(yp + 32 * dt + 8 * gq) = w; }
        }
        __syncthreads();
    }
}


__device__ __forceinline__ void bar4(volatile LAS unsigned* ctr, unsigned& target, int lane) {
    target += 4u;
    asm volatile("s_waitcnt lgkmcnt(0)" ::: "memory");
    if (lane == 0) (void)__hip_atomic_fetch_add((LAS unsigned*)ctr, 1u, __ATOMIC_RELAXED, __HIP_MEMORY_SCOPE_WORKGROUP);
    while (*ctr < target) __builtin_amdgcn_s_sleep(0);
    asm volatile("" ::: "memory");
}
__device__ __forceinline__ void swa4_phase(const bf16* Z, const float* sink, bf16* Y, LAS unsigned char* lds, int tid0, int G, volatile LAS unsigned* ctr) {
    unsigned btarget = 0u;
    const int wave = __builtin_amdgcn_readfirstlane(tid0 >> 6);
    for (int it = blockIdx.x; it < 512; it += G) {
        int tid = tid0; asm volatile("" : "+v"(tid));
        const int lane = tid & 63, r32 = lane & 31, hh = lane >> 5;
        const int tq = (lane & 15) >> 2, tp = lane & 3, tcb = 16 * ((lane >> 4) & 1);
        const int b = it >> 6, blk = (it >> 2) & 15, hk = it & 3;
        const int r0 = b * SEQ + blk * 128 - 128;
#pragma nounroll
        for (int hb = 0; hb < 2; ++hb) {
        v4u kv[4], vv[4];
#pragma unroll
        for (int i = 0; i < 4; ++i) { const int c = tid + 256 * (i + 4 * hb), ki = c >> 3, dc = c & 7;
            if (blk > 0 || ki >= 128) { const bf16* src = Z + (size_t)(r0 + ki) * NZ + hk * 64 + dc * 8; kv[i] = *(const GAS v4u*)(src + ZKA); vv[i] = *(const GAS v4u*)(src + ZVA); }
            else { kv[i] = (v4u){0u, 0u, 0u, 0u}; vv[i] = (v4u){0u, 0u, 0u, 0u}; } }
#pragma unroll
        for (int i = 0; i < 4; ++i) { const int c = tid + 256 * (i + 4 * hb), ki = c >> 3, dc = c & 7;
            *(LAS v4u*)(lds + SW_KOFF + ki * SW_PITCH + dc * 16) = kv[i]; *(LAS v4u*)(lds + SW_VOFF + ki * SW_PITCH + dc * 16) = vv[i]; }
        }
        bar4(ctr, btarget, lane);
#pragma nounroll
        for (int wsl = wave; wsl < 8; wsl += 4) {
        const int hq = 4 * hk + (wsl >> 1);
        const float sk = sink[hq] * pg8::LOG2E;
#pragma nounroll
        for (int qs = 0; qs < 2; ++qs) {
            const int a = 2 * (wsl & 1) + qs, q0 = 32 * a;
            const size_t rowq = (size_t)b * SEQ + blk * 128 + q0 + r32;
            bf16x8 qf[4];
#pragma unroll
            for (int s = 0; s < 4; ++s) qf[s] = *(const GAS bf16x8*)(Z + rowq * NZ + ZQA + hq * 64 + 16 * s + 8 * hh);
            f32x16 sc[5];
#pragma unroll
            for (int j = 0; j < 5; ++j) {
                f32x16 acc = {0.f, 0.f, 0.f, 0.f, 0.f, 0.f, 0.f, 0.f, 0.f, 0.f, 0.f, 0.f, 0.f, 0.f, 0.f, 0.f};
                const LAS unsigned char* kp = lds + SW_KOFF + (32 * (a + j) + r32) * SW_PITCH + 16 * hh;
#pragma unroll
                for (int s = 0; s < 4; ++s) acc = __builtin_amdgcn_mfma_f32_32x32x16_bf16(*(const LAS bf16x8*)(kp + 32 * s), qf[s], acc, 0, 0, 0);
                sc[j] = acc;
            }
            const int qi = q0 + r32;
            float mx = -INFINITY;
#pragma unroll
            for (int j = 0; j < 5; ++j)
#pragma unroll
                for (int rho = 0; rho < 16; ++rho) { const int key = 32 * (a + j) + (rho & 3) + 8 * (rho >> 2) + 4 * hh;
                    const bool ok = (key > qi) && (key <= qi + 128) && (blk > 0 || key >= 128);
                    const float v = ok ? sc[j][rho] : -INFINITY; sc[j][rho] = v; mx = fmaxf(mx, v); }
            mx = fmaxf(mx, __shfl_xor(mx, 32)); mx = fmaxf(mx, sk);
            float ls = 0.f;
#pragma unroll
            for (int j = 0; j < 5; ++j)
#pragma unroll
                for (int rho = 0; rho < 16; ++rho) { const float p = __builtin_amdgcn_exp2f(sc[j][rho] - mx); sc[j][rho] = p; ls += p; }
            ls += __shfl_xor(ls, 32); ls += __builtin_amdgcn_exp2f(sk - mx);
            const float rinv = 1.0f / ls;
            f32x16 oa[2];
            oa[0] = (f32x16){0.f, 0.f, 0.f, 0.f, 0.f, 0.f, 0.f, 0.f, 0.f, 0.f, 0.f, 0.f, 0.f, 0.f, 0.f, 0.f}; oa[1] = oa[0];
#pragma unroll
            for (int j = 0; j < 5; ++j)
#pragma unroll
                for (int s2 = 0; s2 < 2; ++s2) {
                    v4u pw; pw.x = cvt_pk_bf16(sc[j][8 * s2 + 0], sc[j][8 * s2 + 1]); pw.y = cvt_pk_bf16(sc[j][8 * s2 + 2], sc[j][8 * s2 + 3]); pw.z = cvt_pk_bf16(sc[j][8 * s2 + 4], sc[j][8 * s2 + 5]); pw.w = cvt_pk_bf16(sc[j][8 * s2 + 6], sc[j][8 * s2 + 7]);
                    const bf16x8 pf = __builtin_bit_cast(bf16x8, pw);
                    const LAS unsigned char* vp = lds + SW_VOFF + (32 * (a + j) + 16 * s2 + 4 * hh + tq) * SW_PITCH + (tcb + 4 * tp) * 2;
#pragma unroll
                    for (int dt = 0; dt < 2; ++dt) { const bf16x8 vf = mk8(lds_tr(vp + dt * 64), lds_tr(vp + dt * 64 + 8 * SW_PITCH));
                        oa[dt] = __builtin_amdgcn_mfma_f32_32x32x16_bf16(vf, pf, oa[dt], 0, 0, 0); }
                }
            bf16* yp = Y + rowq * DM + hq * 64 + 4 * hh;
#pragma unroll
            for (int dt = 0; dt < 2; ++dt)
#pragma unroll
                for (int gq = 0; gq < 4; ++gq) { v2u w; w.x = cvt_pk_bf16(oa[dt][4 * gq] * rinv, oa[dt][4 * gq + 1] * rinv); w.y = cvt_pk_bf16(oa[dt][4 * gq + 2] * rinv, oa[dt][4 * gq + 3] * rinv);
                    *(GAS v2u*)(yp + 32 * dt + 8 * gq) = w; }
        }
        }
        bar4(ctr, btarget, lane);
    }
}


constexpr int G2_QD = 0, G2_KI = 34816, G2_KE = 69632, G2_QB = 17408, G2_QP = 272;
constexpr int G2_V = 104448, G2_VB = 5120, G2_VP = 80;
constexpr int G2_ST0 = 114688, G2_ST1 = RSTAB_OFF, G2_SP = 272;
constexpr int G2_BL = 123392;
static_assert(G2_ST0 + 32 * G2_SP <= G2_BL && G2_BL + 1024 <= RING_BYTES && G2_ST1 + 32 * G2_SP <= LDS_BYTES, "GLA LDS map");
#define GLA_BAR() asm volatile("s_waitcnt lgkmcnt(0)\n\ts_barrier" ::: "memory")
struct GlaIn { f32x4 b[2][4]; v4u q[2][2], k[2][2], v; };
__device__ __forceinline__ void gla_load(GlaIn& I, const bf16* Z, const float* LA, size_t R0, int h, int es, int pt) {
    const int prow = pt >> 3, pdc = pt & 7;
#pragma unroll
    for (int r = 0; r < 2; ++r) {
        const float* bp = LA + (R0 + prow + 32 * r) * 512 + h * 128 + 8 * pdc; const bf16* zr = Z + (R0 + prow + 32 * r) * NZ + h * 128 + 8 * pdc;
#pragma unroll
        for (int i = 0; i < 2; ++i) { I.b[r][2 * i] = *(const GAS f32x4*)(bp + 64 * i); I.b[r][2 * i + 1] = *(const GAS f32x4*)(bp + 64 * i + 4); I.q[r][i] = *(const GAS v4u*)(zr + ZQB + 64 * i); I.k[r][i] = *(const GAS v4u*)(zr + ZKB + 64 * i); }
    }
    I.v = *(const GAS v4u*)(Z + (R0 + (pt >> 2)) * NZ + ZVB + h * 256 + es * 32 + (pt & 3) * 8);
}
__device__ __forceinline__ void gla_pin(GlaIn& I) {
#pragma unroll
    for (int r = 0; r < 2; ++r) {
#pragma unroll
        for (int k = 0; k < 4; ++k) asm volatile("" : "+v"(I.b[r][k]));
#pragma unroll
        for (int i = 0; i < 2; ++i) { asm volatile("" : "+v"(I.q[r][i])); asm volatile("" : "+v"(I.k[r][i])); }
    }
    asm volatile("" : "+v"(I.v));
}
__device__ __forceinline__ void gla_prep(const GlaIn& I, LAS unsigned char* lds, int buf, int pt) {
    const int prow = pt >> 3, pdc = pt & 7;
#pragma unroll
    for (int r = 0; r < 2; ++r)
#pragma unroll
        for (int i = 0; i < 2; ++i) {
            float qf[8], kf[8]; un8(I.q[r][i], qf); un8(I.k[r][i], kf);
            float x[8], y[8];
#pragma unroll
            for (int j = 0; j < 8; ++j) { const float bb = I.b[r][2 * i + (j >> 2)][j & 3];
                const float e1 = __builtin_amdgcn_exp2f(bb), e2 = __builtin_amdgcn_rcpf(e1);
                x[j] = qf[j] * e1; y[j] = kf[j] * e2; }
            LAS unsigned char* wp = lds + buf * G2_QB + (prow + 32 * r) * G2_QP + (8 * pdc + 64 * i) * 2;
            v4u w;
            w.x = cvt_pk_bf16(x[0], x[1]); w.y = cvt_pk_bf16(x[2], x[3]); w.z = cvt_pk_bf16(x[4], x[5]); w.w = cvt_pk_bf16(x[6], x[7]); *(LAS v4u*)(wp + G2_QD) = w;
            w.x = cvt_pk_bf16(y[0], y[1]); w.y = cvt_pk_bf16(y[2], y[3]); w.z = cvt_pk_bf16(y[4], y[5]); w.w = cvt_pk_bf16(y[6], y[7]); *(LAS v4u*)(wp + G2_KI) = w;
        }
    if (prow == 31) {
#pragma unroll
        for (int i = 0; i < 2; ++i) { *(LAS f32x4*)(lds + G2_BL + buf * 512 + (8 * pdc + 64 * i) * 4) = I.b[1][2 * i]; *(LAS f32x4*)(lds + G2_BL + buf * 512 + (8 * pdc + 64 * i + 4) * 4) = I.b[1][2 * i + 1]; }
    }
    *(LAS v4u*)(lds + G2_V + buf * G2_VB + (pt >> 2) * G2_VP + (pt & 3) * 16) = I.v;
}
__device__ __forceinline__ void glds16_asm(const void* gsrc, unsigned lds_dst) {
    unsigned keep;
    asm volatile("s_mov_b32 %0, m0\n\ts_mov_b32 m0, %2\n\ts_nop 0\n\tglobal_load_lds_dwordx4 %1, off\n\ts_mov_b32 m0, %0" : "=&s"(keep) : "v"(gsrc), "s"(lds_dst) : "memory");
}
__device__ __forceinline__ void side_dma(const TItem& t, int lane, LAS float* scr, LAS float* gscr, const float* ones) {
    const float* p = t.src + (size_t)(lane >> 3) * t.ldw + 4 * (lane & 7);
    const unsigned dst = __builtin_amdgcn_readfirstlane((unsigned)(unsigned long long)scr), gdst = __builtin_amdgcn_readfirstlane((unsigned)(unsigned long long)gscr);
#pragma unroll
    for (int i = 0; i < 8; ++i) glds16_asm(p + (size_t)(8 * i) * t.ldw, dst + i * 1024);
    glds16_asm((t.gk ? t.gk : ones) + 4 * (lane & 15), gdst);
}
__device__ __forceinline__ void side_store(const TItem& t, int lane, LAS float* scr, const LAS float* gscr) {
    const int c = lane & 7;
    const f32x4 g0 = *(const LAS f32x4*)(gscr + 8 * c), g1 = *(const LAS f32x4*)(gscr + 8 * c + 4);
#pragma unroll
    for (int j = 0; j < 4; ++j) { const int n = (lane >> 3) + 8 * j; const LAS float* q = scr + (8 * c) * 32 + n;
        v4u o; o.x = cvt_pk_bf16(q[0 * 32] * g0[0], q[1 * 32] * g0[1]); o.y = cvt_pk_bf16(q[2 * 32] * g0[2], q[3 * 32] * g0[3]); o.z = cvt_pk_bf16(q[4 * 32] * g1[0], q[5 * 32] * g1[1]); o.w = cvt_pk_bf16(q[6 * 32] * g1[2], q[7 * 32] * g1[3]);
        *(GAS v4u*)(t.dst + (size_t)n * t.ldt + 8 * c) = o; }
    LDS_WAIT(); asm volatile("" ::: "memory");
}
__device__ __forceinline__ void mix_a(const bf16* Z, const float* sink, bf16* Y, LAS unsigned char* lds, int tid, int G, const SideJob& J, unsigned char* ws, int nmain, volatile LAS unsigned* ctl) {
    const int wave = __builtin_amdgcn_readfirstlane(tid >> 6);
    if (tid == 0) { ctl[0] = 0u; ctl[1] = 0u; }
    __syncthreads();
    if (wave < 4) swa4_phase(Z, sink, Y, lds, tid, G, ctl);
    int lt = tid & 63; asm volatile("" : "+v"(lt));
    LAS float* scr = (LAS float*)(lds + (wave < 4 ? wave * 16384 : 81920 + (wave - 4) * 8448));
    float sv[32]; f32x4 sg[2];
    for (;;) {
        unsigned j = 0u; if (lt == 0) j = __hip_atomic_fetch_add((LAS unsigned*)(ctl + 1), 1u, __ATOMIC_RELAXED, __HIP_MEMORY_SCOPE_WORKGROUP);
        j = (unsigned)__builtin_amdgcn_readfirstlane((int)j);
        const int gi = (int)j * G + (int)blockIdx.x; if (gi >= nmain) break;
        const TItem d = decode_job(J, ws, gi); titem_load(d, lt, sv, sg); titem_store(d, lt, sv, sg, scr);
    }
    __syncthreads();
}
constexpr int SIDE_GS = 141312;
static_assert(G2_ST1 + 32 * G2_SP <= SIDE_GS && SIDE_GS + 4096 <= LDS_BYTES, "GLA LDS map");
constexpr int SIDE_SCR = G2_KE;
static_assert(SIDE_SCR + 4 * 8192 <= G2_V, "GLA LDS map");
__device__ __forceinline__ void gla_phase(const bf16* Z, const float* LA, float* OS, LAS unsigned char* lds, int tid, int G, const SideJob& J, unsigned char* ws) {
    const int lane = tid & 63, wave = __builtin_amdgcn_readfirstlane(tid >> 6), r32 = lane & 31, hh = lane >> 5;
    const int tq = (lane & 15) >> 2, tp = lane & 3, tcb = 16 * ((lane >> 4) & 1);
    const f32x16 zero16 = {0.f, 0.f, 0.f, 0.f, 0.f, 0.f, 0.f, 0.f, 0.f, 0.f, 0.f, 0.f, 0.f, 0.f, 0.f, 0.f};
    const int nmain = J.l == 0 ? NS_ITEMS + I_IN : NS_ITEMS;
    bool side_first = true;
    for (int it = blockIdx.x; it < 256; it += G) {
        const int b = it & 7, h = (it >> 3) & 3, es = it >> 5;
        const size_t R00 = (size_t)b * SEQ;
        for (int i = tid; i < 32 * G2_SP / 16; i += NWAVES * 64) *(LAS v4u*)(lds + G2_ST0 + i * 16) = (v4u){0u, 0u, 0u, 0u};
        if (wave >= 4) {
            const int pt = tid - 256;
            GlaIn IA, IB;
            __builtin_amdgcn_s_waitcnt(0x0F70);
            gla_load(IA, Z, LA, R00, h, es, pt);
            gla_prep(IA, lds, 0, pt);
            gla_load(IA, Z, LA, R00 + 64, h, es, pt);
            asm volatile("" ::: "memory");
            gla_load(IB, Z, LA, R00 + 128, h, es, pt);
            GLA_BAR();
            for (int t = 0; t < 32; t += 2) {
                gla_pin(IA); gla_prep(IA, lds, 1, pt);
                gla_load(IA, Z, LA, R00 + 64 * (t + 3 < 32 ? t + 3 : 31), h, es, pt);
                GLA_BAR();
                gla_pin(IB); gla_prep(IB, lds, 0, pt);
                gla_load(IB, Z, LA, R00 + 64 * (t + 4 < 32 ? t + 4 : 31), h, es, pt);
                GLA_BAR();
            }
        } else {
            f32x16 S0 = zero16, S1 = zero16;
            const bool side_on = false;
            LAS float* sscr = (LAS float*)(lds + SIDE_SCR + (wave >= 2 ? wave - 2 : 0) * 16384);
            LAS float* sgs = (LAS float*)(lds + SIDE_GS + (wave >= 2 ? wave - 2 : 0) * 2048);
            const float* ones = (const float*)(ws + WS_ONES);
            if (side_on) {
#pragma unroll
                for (int j = 0; j < 2; ++j) { const int gi = (2 * j + (wave - 2)) * G + (int)blockIdx.x; if (gi < nmain) { const TItem d = decode_job(J, ws, gi); side_dma(d, lane, sscr + j * 2048, sgs + j * 256, ones); } }
            }
            GLA_BAR();
            for (int t = 0; t < 32; ++t) {
                const int buf = t & 1;
                if (wave < 2) {
                    const int lt = wave;
                    const LAS unsigned char* qdp = lds + G2_QD + buf * G2_QB + (32 * lt + r32) * G2_QP + 16 * hh;
                    const LAS unsigned char* stp = lds + (buf ? G2_ST1 : G2_ST0) + r32 * G2_SP + 16 * hh;
                    const LAS unsigned char* kip = lds + G2_KI + buf * G2_QB + r32 * G2_QP + 16 * hh;
                    bf16x8 qf[8], fr[8];
#pragma unroll
                    for (int ks = 0; ks < 8; ++ks) { qf[ks] = *(const LAS bf16x8*)(qdp + 32 * ks); fr[ks] = *(const LAS bf16x8*)(kip + 32 * ks); }
                    f32x16 a = zero16, o = zero16;
#pragma unroll
                    for (int ks = 0; ks < 8; ++ks) a = __builtin_amdgcn_mfma_f32_32x32x16_bf16(fr[ks], qf[ks], a, 0, 0, 0);
#pragma unroll
                    for (int ks = 0; ks < 8; ++ks) fr[ks] = *(const LAS bf16x8*)(stp + 32 * ks);
#pragma unroll
                    for (int ks = 0; ks < 8; ++ks) o = __builtin_amdgcn_mfma_f32_32x32x16_bf16(fr[ks], qf[ks], o, 0, 0, 0);
                    if (lt == 1) {
#pragma unroll
                        for (int ks = 0; ks < 8; ++ks) fr[ks] = *(const LAS bf16x8*)(kip + 32 * G2_QP + 32 * ks);
                    }
                    const LAS unsigned char* vp = lds + G2_V + buf * G2_VB + (4 * hh + tq) * G2_VP + (tcb + 4 * tp) * 2;
                    if (lt == 0) {
#pragma unroll
                        for (int rho = 0; rho < 16; ++rho) { const int sr = (rho & 3) + 8 * (rho >> 2) + 4 * hh; a[rho] = r32 >= sr ? a[rho] : 0.f; }
                    }
#pragma unroll
                    for (int s2 = 0; s2 < 2; ++s2) {
                        v4u pw; pw.x = cvt_pk_bf16(a[8 * s2 + 0], a[8 * s2 + 1]); pw.y = cvt_pk_bf16(a[8 * s2 + 2], a[8 * s2 + 3]); pw.z = cvt_pk_bf16(a[8 * s2 + 4], a[8 * s2 + 5]); pw.w = cvt_pk_bf16(a[8 * s2 + 6], a[8 * s2 + 7]);
                        const bf16x8 vf = mk8(lds_tr(vp + 16 * s2 * G2_VP), lds_tr(vp + (16 * s2 + 8) * G2_VP));
                        o = __builtin_amdgcn_mfma_f32_32x32x16_bf16(vf, __builtin_bit_cast(bf16x8, pw), o, 0, 0, 0);
                    }
                    if (lt == 1) {
                        a = zero16;
#pragma unroll
                        for (int ks = 0; ks < 8; ++ks) a = __builtin_amdgcn_mfma_f32_32x32x16_bf16(fr[ks], qf[ks], a, 0, 0, 0);
#pragma unroll
                        for (int rho = 0; rho < 16; ++rho) { const int sr = (rho & 3) + 8 * (rho >> 2) + 4 * hh; a[rho] = r32 >= sr ? a[rho] : 0.f; }
#pragma unroll
                        for (int s2 = 0; s2 < 2; ++s2) {
                            v4u pw; pw.x = cvt_pk_bf16(a[8 * s2 + 0], a[8 * s2 + 1]); pw.y = cvt_pk_bf16(a[8 * s2 + 2], a[8 * s2 + 3]); pw.z = cvt_pk_bf16(a[8 * s2 + 4], a[8 * s2 + 5]); pw.w = cvt_pk_bf16(a[8 * s2 + 6], a[8 * s2 + 7]);
                            const bf16x8 vf = mk8(lds_tr(vp + (32 + 16 * s2) * G2_VP), lds_tr(vp + (32 + 16 * s2 + 8) * G2_VP));
                            o = __builtin_amdgcn_mfma_f32_32x32x16_bf16(vf, __builtin_bit_cast(bf16x8, pw), o, 0, 0, 0);
                        }
                    }
                    bf16* op = (bf16*)OS + (R00 + 64 * t + 32 * wave + r32) * 1024 + h * 256 + es * 32 + 4 * hh;
#pragma unroll
                    for (int g = 0; g < 4; ++g) { v2u w; w.x = cvt_pk_bf16(o[4 * g], o[4 * g + 1]); w.y = cvt_pk_bf16(o[4 * g + 2], o[4 * g + 3]); *(GAS v2u*)(op + 8 * g) = w; }
                } else {
                    LAS unsigned char* stn = lds + (buf ? G2_ST0 : G2_ST1);
                    const LAS unsigned char* vp = lds + G2_V + buf * G2_VB + (8 * hh + tq) * G2_VP + (tcb + 4 * tp) * 2;
                    const LAS unsigned char* kp = lds + G2_KI + buf * G2_QB + (8 * hh + tq) * G2_QP + (64 * (wave - 2) + tcb + 4 * tp) * 2;
                    bf16x8 vf8[4], k0[4], k1[4];
#pragma unroll
                    for (int ks = 0; ks < 4; ++ks) { vf8[ks] = mk8(lds_tr(vp + 16 * ks * G2_VP), lds_tr(vp + (16 * ks + 4) * G2_VP));
                        k0[ks] = mk8(lds_tr(kp + 16 * ks * G2_QP), lds_tr(kp + (16 * ks + 4) * G2_QP)); k1[ks] = mk8(lds_tr(kp + 64 + 16 * ks * G2_QP), lds_tr(kp + 64 + (16 * ks + 4) * G2_QP)); }
#pragma unroll
                    for (int ks = 0; ks < 4; ++ks) { S0 = __builtin_amdgcn_mfma_f32_32x32x16_bf16(k0[ks], vf8[ks], S0, 0, 0, 0); S1 = __builtin_amdgcn_mfma_f32_32x32x16_bf16(k1[ks], vf8[ks], S1, 0, 0, 0); }
#pragma unroll
                    for (int rho = 0; rho < 16; ++rho) { const LAS float* bp = (const LAS float*)(lds + G2_BL + buf * 512) + 64 * (wave - 2) + (rho & 3) + 8 * (rho >> 2) + 4 * hh; S0[rho] *= __builtin_amdgcn_exp2f(bp[0]); S1[rho] *= __builtin_amdgcn_exp2f(bp[32]); }
#pragma unroll
                    for (int g = 0; g < 4; ++g) {
                        v2u w; w.x = cvt_pk_bf16(S0[4 * g], S0[4 * g + 1]); w.y = cvt_pk_bf16(S0[4 * g + 2], S0[4 * g + 3]); *(LAS v2u*)(stn + r32 * G2_SP + (64 * (wave - 2) + 8 * g + 4 * hh) * 2) = w;
                        w.x = cvt_pk_bf16(S1[4 * g], S1[4 * g + 1]); w.y = cvt_pk_bf16(S1[4 * g + 2], S1[4 * g + 3]); *(LAS v2u*)(stn + r32 * G2_SP + (64 * (wave - 2) + 32 + 8 * g + 4 * hh) * 2) = w;
                    }
                    if (side_on) {
                        { const int gnx = (2 * (t + 1) + (wave - 2)) * G + (int)blockIdx.x;
                          if (t + 1 < 32 && gnx < nmain) { if (t == 0) asm volatile("s_waitcnt vmcnt(9)" ::: "memory"); else asm volatile("s_waitcnt vmcnt(13)" ::: "memory"); } else asm volatile("s_waitcnt vmcnt(0)" ::: "memory"); }
                        LAS float* sb = sscr + buf * 2048; LAS float* gb = sgs + buf * 256;
                        int ls = lane; asm volatile("" : "+v"(ls));
                        const int gi = (2 * t + (wave - 2)) * G + (int)blockIdx.x;
                        if (gi < nmain) { const TItem d = decode_job(J, ws, gi); side_store(d, ls, sb, gb); }
                        const int gn = (2 * (t + 2) + (wave - 2)) * G + (int)blockIdx.x;
                        if (t + 2 < 32 && gn < nmain) { const TItem d = decode_job(J, ws, gn); side_dma(d, ls, sb, gb, ones); }
                    }
                }
                GLA_BAR();
            }
        }
        __syncthreads();
        side_first = false;
    }
    {
        float sv[32]; f32x4 sg[2];
        LAS float* scr = (LAS float*)(lds + RING_OFF + wave * 16384);
        if (J.l == 0) for (int r = (int)blockIdx.x * NWAVES + wave; r < I_AL; r += G * NWAVES) { const int kb = r / 16, jb = r % 16; alpha_item((const float*)J.ap->in[3] + (size_t)DM * WIN_LD, (const float*)J.ap->in[5] + 16 * 512, (const float*)J.ap->in[2] + DM, kb * 64, jb * 32, (bf16*)(ws + WS_WIN), scr, lane); }
    }
}
__device__ __forceinline__ void yb_norm(const float* OS, const bf16* Z, const float* gg, bf16* Y, int gw, int NGW, int lane) {
    const f32x4 g = *(const GAS f32x4*)(gg + 4 * lane);
    for (int item0 = gw * 4; item0 < M * 4; item0 += NGW * 4) {
        f32x4 o[4]; v2u r[4]; float ss[4];
#pragma unroll
        for (int k = 0; k < 4; ++k) { const int item = item0 + k, row = item >> 2, h = item & 3;
            { const v2u ow = *(const GAS v2u*)((const bf16*)OS + (size_t)row * 1024 + h * 256 + 4 * lane); o[k] = (f32x4){bflo(ow.x), bfhi(ow.x), bflo(ow.y), bfhi(ow.y)}; } r[k] = *(const GAS v2u*)(Z + (size_t)row * NZ + ZRB + h * 256 + 4 * lane);
            ss[k] = (o[k].x * o[k].x + o[k].y * o[k].y) + (o[k].z * o[k].z + o[k].w * o[k].w); }
#pragma unroll
        for (int off = 1; off < 64; off <<= 1) {
#pragma unroll
            for (int k = 0; k < 4; ++k) ss[k] += __shfl_xor(ss[k], off); }
#pragma unroll
        for (int k = 0; k < 4; ++k) { const int item = item0 + k, row = item >> 2, h = item & 3;
            const float rs = 1.0f / sqrtf(ss[k] * (1.0f / 256.0f) + pg8::RMS_EPS);
            v2u w; w.x = cvt_pk_bf16(o[k].x * rs * g.x * bflo(r[k].x), o[k].y * rs * g.y * bfhi(r[k].x)); w.y = cvt_pk_bf16(o[k].z * rs * g.z * bflo(r[k].y), o[k].w * rs * g.w * bfhi(r[k].y));
            *(GAS v2u*)(Y + (size_t)row * DM + 1024 + h * 256 + 4 * lane) = w; }
    }
}
__device__ __forceinline__ void conv_fixup(const bf16* HF, const bf16* HL, const float* cw, const float* cb, bf16* ACT, int pm, int tid) {
    for (int cg = tid; cg < 704; cg += NWAVES * 64) {
        const int c0 = cg * 8, pn = c0 >> 7, j0 = c0 & 127, hcol = 256 * pn + j0;
        const bool first = (pm & 7) == 0;
        float h[4][2][8];
#pragma unroll
        for (int k = 0; k < 2; ++k)
#pragma unroll
            for (int gu = 0; gu < 2; ++gu) {
                v4u a = {0u, 0u, 0u, 0u};
                if (!first) a = *(const GAS v4u*)(HL + (size_t)((pm - 1) * 2 + k) * NH + hcol + 128 * gu);
                const v4u b = *(const GAS v4u*)(HF + (size_t)(pm * 2 + k) * NH + hcol + 128 * gu);
                un8h(a, h[k][gu]); un8h(b, h[2 + k][gu]);
            }
#pragma unroll
        for (int k = 0; k < 2; ++k) {
            float a[8];
#pragma unroll
            for (int i = 0; i < 8; ++i) {
                const int c = c0 + i;
                const float gc = cb[c] + cw[c] * h[k][0][i] + cw[NH + c] * h[k + 1][0][i] + cw[2 * NH + c] * h[k + 2][0][i];
                const float uc = cb[DFF + c] + cw[DFF + c] * h[k][1][i] + cw[NH + DFF + c] * h[k + 1][1][i] + cw[2 * NH + DFF + c] * h[k + 2][1][i];
                a[i] = gc * pg8::sigmoidf_fast(gc) * uc;
            }
            v4u w; w.x = cvt_pk_bf16(a[0], a[1]); w.y = cvt_pk_bf16(a[2], a[3]); w.z = cvt_pk_bf16(a[4], a[5]); w.w = cvt_pk_bf16(a[6], a[7]);
            *(GAS v4u*)(ACT + (size_t)(pm * 256 + k) * DFF + c0) = w;
        }
    }
}
__device__ __forceinline__ void final_norm(const bf16* xb, float* out, const float* fg, int gw, int NGW, int lane) {
    for (int m0 = gw * 2; m0 < M; m0 += NGW * 2) {
        v4u v[2][4]; float s[2] = {0.f, 0.f};
#pragma unroll
        for (int k = 0; k < 2; ++k) { const GAS v4u* xr = (const GAS v4u*)(xb + (size_t)(m0 + k) * DM) + lane;
#pragma unroll
            for (int j = 0; j < 4; ++j) { v[k][j] = xr[64 * j]; float f[8]; un8(v[k][j], f);
#pragma unroll
                for (int i = 0; i < 8; ++i) s[k] += f[i] * f[i]; } }
#pragma unroll
        for (int off = 1; off < 64; off <<= 1) { s[0] += __shfl_xor(s[0], off); s[1] += __shfl_xor(s[1], off); }
#pragma unroll
        for (int k = 0; k < 2; ++k) { const float rs = 1.0f / sqrtf(s[k] * (1.0f / DM) + pg8::RMS_EPS);
#pragma unroll
            for (int j = 0; j < 4; ++j) { float f[8]; un8(v[k][j], f); const GAS f32x4* gr = (const GAS f32x4*)(fg + 8 * lane + 512 * j); GAS f32x4* orow = (GAS f32x4*)(out + (size_t)(m0 + k) * DM + 8 * lane + 512 * j);
                const f32x4 g0 = gr[0], g1 = gr[1];
                orow[0] = (f32x4){f[0] * rs * g0[0], f[1] * rs * g0[1], f[2] * rs * g0[2], f[3] * rs * g0[3]}; orow[1] = (f32x4){f[4] * rs * g1[0], f[5] * rs * g1[1], f[6] * rs * g1[2], f[7] * rs * g1[3]}; } }
    }
}
__global__ void __launch_bounds__(NWAVES * 64, 2) fwd(Args args) {
    extern __shared__ __attribute__((aligned(16))) unsigned char lds_raw[];
    LAS unsigned char* lds = (LAS unsigned char*)lds_raw;
    volatile LAS unsigned* MISC = (volatile LAS unsigned*)(lds + MISC_OFF);
    const int wave_s = __builtin_amdgcn_readfirstlane((int)threadIdx.x >> 6);
    const int G = gridDim.x, NGW = G * NWAVES, NT = G * NWAVES * 64;
    {
        const int tid = threadIdx.x;
        for (int u = tid; u < (LDS_BYTES - LDSCTL_OFF) / 4 && u < 256; u += NWAVES * 64) ((LAS unsigned*)(lds + LDSCTL_OFF))[u] = 0u;
    }
    __syncthreads();
    XcdBarrier bar = xcd_barrier_post((unsigned*)((gu32*)(args.ws + WS_CTL) + CW_BAR), MISC + 8);
    const int lo = args.ph_lo, hi = args.ph_hi;
#define IN(p) (lo <= (p) && (p) < hi)
#define SEAM(p) do { if (IN(p) && IN((p) + 1)) { XcdBarrier b2 = bar; asm volatile("" : "+s"(b2.x)); xcd_barrier(b2); } } while (0)

    for (int l = 0; l < 2; ++l) {
        const int pb = 9 * l;
#define INP(k) ((const float*)ap->in[k])
#define PHASE_IDS() const __attribute__((address_space(4))) Args* ap = (const __attribute__((address_space(4))) Args*)__builtin_amdgcn_kernarg_segment_ptr(); asm volatile("" : "+s"(ap)); unsigned char* const ws = ap->ws; (void)ws; unsigned ones_ = ~0u; asm volatile("" : "+s"(ones_)); int tidp = wave_s * 64 + (int)__builtin_amdgcn_mbcnt_hi(ones_, __builtin_amdgcn_mbcnt_lo(ones_, 0u)); asm volatile("" : "+v"(tidp)); const int lanep = tidp & 63, wavep = __builtin_amdgcn_readfirstlane(tidp >> 6), gwp = blockIdx.x * NWAVES + wavep, gtp = blockIdx.x * (NWAVES * 64) + tidp; (void)lanep; (void)gwp; (void)gtp
        if (IN(pb + 0) && l == 0) { PHASE_IDS();
            LayerIn L;
            L.gmix = INP(2); L.win = INP(3); L.wau = INP(5);
            phase_weights(L, ws, lds, gwp, NGW, wavep, lanep);
            phase_xprep(INP(0), (const int*)ap->in[1], ws, gwp, NGW, lanep);
        }
        if (l == 0) SEAM(pb + 0);
        if (IN(pb + 1)) { PHASE_IDS();
            pg8::Gemm g{(bf16*)(ws + WS_XB), (bf16*)(ws + WS_WIN), M, NZ, DM, DM, nullptr, nullptr}; pg8::StaticOrder S; S.init(M, NZ, G, (int)blockIdx.x);
            fill_rstd_table((float*)(ws + WS_SSQ), lds, tidp);
            pg8::EpiZ E{(bf16*)(ws + WS_ZB), (float*)(ws + WS_LA), (const LAS float*)(lds + RSTAB_OFF), (float*)(ws + WS_ROPE), INP(6) + l * 512};
            pg8::gemm_phase<pg8::EpiZ, pg8::StaticOrder, true, true>(lds + RING_OFF, g, S, E, tidp);
        }
        SEAM(pb + 1);
        if (IN(pb + 2)) { PHASE_IDS(); SideJob J; J.ap = ap; J.l = l; mix_a((bf16*)(ws + WS_ZB), INP(4) + l * 16, (bf16*)(ws + WS_Y), lds, tidp, G, J, ws, l == 0 ? NS_ITEMS + I_IN : NS_ITEMS, MISC + 16); int tid2 = tidp; asm volatile("" : "+v"(tid2)); gla_phase((bf16*)(ws + WS_ZB), (float*)(ws + WS_LA), ap->out, lds, tid2, G, J, ws); }
        SEAM(pb + 2);
        if (IN(pb + 3)) { PHASE_IDS(); yb_norm(ap->out, (bf16*)(ws + WS_ZB), INP(7) + l * 256, (bf16*)(ws + WS_Y), gwp, NGW, lanep); }
        SEAM(pb + 3);
        if (IN(pb + 4)) { PHASE_IDS();
            pg8::Gemm g{(bf16*)(ws + WS_Y), (bf16*)(ws + WS_WA), M, DM, 1024, DM, (bf16*)(ws + WS_Y) + 1024, (bf16*)(ws + WS_WB)}; pg8::TwoSegOrder S; S.init(M, DM, G, (int)blockIdx.x);
            pg8::EpiMix E{(bf16*)(ws + WS_MIX), (bf16*)(ws + WS_ZB) + ZGA, (bf16*)(ws + WS_ZB) + ZGB};
            pg8::gemm_phase<pg8::EpiMix, pg8::TwoSegOrder, true, true>(lds + RING_OFF, g, S, E, tidp);
        }
        SEAM(pb + 4);
        if (IN(pb + 5)) { PHASE_IDS();
            pg8::Gemm g{(bf16*)(ws + WS_MIX), (bf16*)(ws + WS_WO), M, DM, DM, DM, nullptr, nullptr}; pg8::StaticOrder S; S.init(M, DM, G, (int)blockIdx.x);
            pg8::EpiRes E{(bf16*)(ws + WS_XB), (float*)(ws + WS_SSQ)};
            pg8::gemm_phase<pg8::EpiRes, pg8::StaticOrder, true, true>(lds + RING_OFF, g, S, E, tidp);
        }
        SEAM(pb + 5);
        if (IN(pb + 6)) { PHASE_IDS();
            pg8::Gemm g{(bf16*)(ws + WS_XB), (bf16*)(ws + WS_WUP), M, NH, DM, DM, nullptr, nullptr}; pg8::StaticOrder S; S.init(M, NH, G, (int)blockIdx.x);
            fill_rstd_table((float*)(ws + WS_SSQ), lds, tidp);
            pg8::EpiUp E{(bf16*)(ws + WS_ACT), (const LAS float*)(lds + RSTAB_OFF), (LAS unsigned*)(lds + XL_OFF), (LAS unsigned*)(lds + CWL_OFF), INP(13) + (size_t)l * 3 * NH, INP(14) + (size_t)l * NH, (bf16*)(ws + WS_HF), (bf16*)(ws + WS_HL)};
            pg8::gemm_phase<pg8::EpiUp, pg8::StaticOrder, true, true>(lds + RING_OFF, g, S, E, tidp);
        }
        SEAM(pb + 6);
        if (IN(pb + 8)) { PHASE_IDS();
            pg8::Gemm g{(bf16*)(ws + WS_ACT), (bf16*)(ws + WS_WDN), M, DM, DFF, DFF, nullptr, nullptr}; pg8::StaticOrder S; S.init(M, DM, G, (int)blockIdx.x);
            {
                pg8::Unit uu; int prev = -1;
                for (int i = 0; S.next(i, uu); ++i) if (uu.pm != prev) { prev = uu.pm; conv_fixup((bf16*)(ws + WS_HF), (bf16*)(ws + WS_HL), INP(13) + (size_t)l * 3 * NH, INP(14) + (size_t)l * NH, (bf16*)(ws + WS_ACT), uu.pm, tidp); }
                asm volatile("s_waitcnt vmcnt(0)" ::: "memory"); __syncthreads();
            }
            pg8::EpiRes E{(bf16*)(ws + WS_XB), (float*)(ws + WS_SSQ)};
            pg8::gemm_phase<pg8::EpiRes, pg8::StaticOrder, true, true>(lds + RING_OFF, g, S, E, tidp);
        }
        SEAM(pb + 8);
    }
    if (IN(18)) { PHASE_IDS(); final_norm((const bf16*)(ws + WS_XB), ap->out, (const float*)ap->in[16], gwp, NGW, lanep); }
#undef IN
#undef SEAM
}

#ifndef N_LAUNCH_MODE
#define N_LAUNCH_MODE 1
#endif
extern "C" void kernel_launch(void* const* d_in, const int* in_sizes, int n_in, void* d_out, int out_size, void* d_ws, size_t ws_size, hipStream_t stream) {
    static int grid = 0;
    if (grid == 0) {
        if (n_in != 17 || out_size != M * DM || ws_size < WS_END) { fprintf(stderr, "kernel_launch: unexpected shapes (n_in %d out %d ws %zu)\n", n_in, out_size, ws_size); grid = -1; return; }
        int dev = 0, cus = 0, per_cu = 0;
        if (hipGetDevice(&dev) != hipSuccess || hipDeviceGetAttribute(&cus, hipDeviceAttributeMultiprocessorCount, dev) != hipSuccess) { grid = -1; return; }
        if (hipFuncSetAttribute((const void*)fwd, hipFuncAttributeMaxDynamicSharedMemorySize, LDS_BYTES) != hipSuccess) { fprintf(stderr, "kernel_launch: hipFuncSetAttribute failed\n"); grid = -1; return; }
        if (hipOccupancyMaxActiveBlocksPerMultiprocessor(&per_cu, (const void*)fwd, NWAVES * 64, LDS_BYTES) != hipSuccess || per_cu < 1) fprintf(stderr, "kernel_launch: occupancy query reports %d\n", per_cu);
        (void)hipGetLastError();
        grid = cus;
        if (grid % 8 != 0) { fprintf(stderr, "kernel_launch: CU count %d is not a multiple of 8 (the per-CU row-statistics table assumes it)\n", grid); grid = -1; return; }
    }
    if (grid < 0) return;
    if (hipMemsetAsync((char*)d_ws + WS_CTL, 0, CTL_ZERO_BYTES, stream) != hipSuccess) return;
    Args a{};
    for (int i = 0; i < 17; ++i) a.in[i] = d_in[i];
    a.out = (float*)d_out; a.ws = (unsigned char*)d_ws;
    if (N_LAUNCH_MODE == 1) { a.ph_lo = 0; a.ph_hi = N_PHASES; hipLaunchKernelGGL(fwd, dim3(grid), dim3(NWAVES * 64), LDS_BYTES, stream, a); }
    else for (int p = 0; p < N_PHASES; ++p) { a.ph_lo = p; a.ph_hi = p + 1; hipLaunchKernelGGL(fwd, dim3(grid), dim3(NWAVES * 64), LDS_BYTES, stream, a); }
}
```

```cpp
#include <hip/hip_runtime.h>
#include <cstdio>
#include <cstdint>
#include <cmath>
namespace pg8 {
#define PG8_LAS __attribute__((address_space(3)))
typedef unsigned short bf16_t;
typedef short bf16x8 __attribute__((ext_vector_type(8)));
typedef float f32x4 __attribute__((ext_vector_type(4)));
typedef unsigned u32x4 __attribute__((ext_vector_type(4)));
constexpr int BM = 256, BK = 64, HALF = 128, HTB = HALF * BK * 2  , STAGE_BYTES = 8 * HTB, NXCD = 8, WGM = 8;

__host__ __device__ __forceinline__ int lds_byte(int r, int c) { const int st = (r >> 4) * 2 + (c >> 5), rr = r & 15, cc = c & 31, ob = rr * 64 + cc * 2; return st * 1024 + (ob ^ (((ob >> 9) & 1) << 5)); }
__host__ __device__ __forceinline__ void stage_rc(int b, int& R, int& C) { const int st = b / 1024, sb = b % 1024, swz = sb ^ (((sb >> 9) & 1) << 5); R = (st >> 1) * 16 + swz / 64; C = (st & 1) * 32 + (swz % 64) / 2; }
__host__ __device__ __forceinline__ int perm32(int rho) { const int n = rho >> 4, i = rho & 15; return 8 * (i >> 2) + 4 * n + (i & 3); }

struct Unit { int pm, pn, seg; };
struct Gemm { const bf16_t* A; const bf16_t* Bt; int M, N, K, lda; const bf16_t* A1; const bf16_t* Bt1; };

struct StaticOrder {
    int nM, nN, nwg, G, c;
    __host__ __device__ void init(int M, int N, int G_, int c_) { nM = M / BM; nN = N / BM; nwg = nM * nN; G = G_; c = c_; }
    __host__ __device__ bool next(int i, Unit& u) const {
        const long L = (long)i * G + c; if (L >= nwg) return false;
        int wgid = (int)L; { const int q = nwg / NXCD, r = nwg % NXCD, xcd = wgid % NXCD, off = wgid / NXCD; wgid = (xcd < r ? xcd * (q + 1) : r * (q + 1) + (xcd - r) * q) + off; }
        const int nig = WGM * nN, gid = wgid / nig, fm = gid * WGM, gsz = (nM - fm) < WGM ? (nM - fm) : WGM;
        u.pm = fm + ((wgid % nig) % gsz); u.pn = (wgid % nig) / gsz; u.seg = 0; return true;
    }
    __device__ __forceinline__ void a_ready(const Unit&) const {}
    __device__ __forceinline__ void done(const Unit&) const {}
};

struct TwoSegOrder : StaticOrder {
    __host__ __device__ bool next(int i, Unit& u) const { if (!StaticOrder::next(i >> 1, u)) return false; u.seg = i & 1; return true; }
};
typedef float f32x2_t __attribute__((ext_vector_type(2))); typedef __bf16 bf16x2_t __attribute__((ext_vector_type(2)));
__device__ __forceinline__ unsigned cvt_pk_bf16(float lo, float hi) { const f32x2_t v = {lo, hi}; const bf16x2_t b = __builtin_convertvector(v, bf16x2_t); return __builtin_bit_cast(unsigned, b); }
__device__ __forceinline__ u32x4 pack8(f32x4 a, f32x4 b) { u32x4 w; w.x = cvt_pk_bf16(a[0], a[1]); w.y = cvt_pk_bf16(a[2], a[3]); w.z = cvt_pk_bf16(b[0], b[1]); w.w = cvt_pk_bf16(b[2], b[3]); return w; }
__device__ __forceinline__ f32x4 unlo(u32x4 w) { return (f32x4){__uint_as_float(w.x << 16), __uint_as_float(w.x & 0xffff0000u), __uint_as_float(w.y << 16), __uint_as_float(w.y & 0xffff0000u)}; }
__device__ __forceinline__ f32x4 unhi(u32x4 w) { return (f32x4){__uint_as_float(w.z << 16), __uint_as_float(w.z & 0xffff0000u), __uint_as_float(w.w << 16), __uint_as_float(w.w & 0xffff0000u)}; }

constexpr int NZ = 9216;
constexpr int ZQA = 0, ZKA = 1024, ZVA = 1280, ZQB = 1536, ZKB = 2048, ZVB = 2560, ZRB = 3584, ZAL = 4608, ZGA = 5120, ZGB = 7168;
constexpr float LOG2E = 1.4426950408889634f;
constexpr float QA_SCALE = 0.125f * LOG2E;
constexpr float QB_SCALE = 0.08838834764831845f;
constexpr float RMS_EPS = 1e-6f;

__device__ __forceinline__ float row_rstd(const float* ssq, int row, int fq) {
    const f32x4* p = (const f32x4*)(ssq + (size_t)row * 32 + fq * 8);
    const f32x4 a = p[0], b = p[1];
    float s = ((a[0] + a[1]) + (a[2] + a[3])) + ((b[0] + b[1]) + (b[2] + b[3]));
    s += __shfl_xor(s, 16); s += __shfl_xor(s, 32);
    return 1.0f / sqrtf(s * (1.0f / 2048.0f) + RMS_EPS);
}
__device__ __forceinline__ float sigmoidf_fast(float x) { return __builtin_amdgcn_rcpf(1.0f + __expf(-x)); }

template <int CTRL, bool ZFILL> __device__ __forceinline__ float dppf(float x) { return __builtin_bit_cast(float, __builtin_amdgcn_update_dpp(0, __builtin_bit_cast(int, x), CTRL, 0xf, 0xf, ZFILL)); }
struct EpiZ {
    static constexpr bool PERM = true, AFTER_DRAIN = false; static __device__ __forceinline__ bool keeps_acc(const Unit&) { return false; }
    bf16_t* Z; float* LA; const PG8_LAS float* rsl; const float* cs; const float* balpha;
    __device__ __forceinline__ void operator()(const f32x4 (&acc)[2][2][4][2], const Unit& u, int wr, int wc, int fr, int fq) const {
        const int pn = u.pn, row0 = u.pm * BM + wr * 64 + fr, colw = wc * 32 + 8 * fq;
        float rs[2][4];
#pragma unroll
        for (int ai = 0; ai < 2; ++ai)
#pragma unroll
            for (int m = 0; m < 4; ++m) rs[ai][m] = rsl[(row0 + ai * HALF + m * 16) & 2047];
        if (pn < 5) {
            const bool rot = (wc & 1) == 0;
            const float post = pn < 4 ? QA_SCALE : 1.0f;
            const float sgn = fq == 0 ? -1.0f : (fq == 1 ? 1.0f : 0.0f);
#pragma unroll
            for (int ai = 0; ai < 2; ++ai)
#pragma unroll
            for (int mb = 0; mb < 4; mb += 2) {
                f32x4 ct[2][4];
                if (rot) {
#pragma unroll
                    for (int mm = 0; mm < 2; ++mm) { const f32x4* cp = (const f32x4*)(cs + (size_t)(row0 + ai * HALF + (mb + mm) * 16) * 16);
#pragma unroll
                        for (int q = 0; q < 4; ++q) ct[mm][q] = cp[q]; }
                }
                asm volatile("" ::: "memory");
#pragma unroll
                for (int mm = 0; mm < 2; ++mm) {
                    const int m = mb + mm, row = row0 + ai * HALF + m * 16;
                    const float sc = rs[ai][m] * post;
                    f32x4 v[2][2];
#pragma unroll
                    for (int bj = 0; bj < 2; ++bj)
#pragma unroll
                        for (int n = 0; n < 2; ++n) v[bj][n] = acc[ai][bj][m][n] * sc;
                    if (rot) {
                        float cc[8], sn[8];
#pragma unroll
                        for (int j = 0; j < 8; ++j) { cc[j] = fq < 2 ? ct[mm][j >> 1][2 * (j & 1)] : 1.0f; sn[j] = ct[mm][j >> 1][2 * (j & 1) + 1] * sgn; }
#pragma unroll
                        for (int bj = 0; bj < 2; ++bj)
#pragma unroll
                            for (int n = 0; n < 2; ++n)
#pragma unroll
                                for (int i = 0; i < 4; ++i) { const float own = v[bj][n][i], oth = __shfl_xor(own, 16); v[bj][n][i] = own * cc[4 * n + i] + oth * sn[4 * n + i]; }
                    }
                    bf16_t* rowp = Z + (size_t)row * NZ + pn * BM + colw;
#pragma unroll
                    for (int bj = 0; bj < 2; ++bj) *(u32x4*)(rowp + bj * HALF) = pack8(v[bj][0], v[bj][1]);
                }
                asm volatile("" ::: "memory");
            }
        } else if (pn == 18 || pn == 19) {
            f32x4 bb[2][2];
#pragma unroll
            for (int bj = 0; bj < 2; ++bj)
#pragma unroll
                for (int n = 0; n < 2; ++n) bb[bj][n] = *(const f32x4*)(balpha + (pn - 18) * 256 + bj * HALF + colw + 4 * n);
            const int l15 = (fq * 16 + 15) * 4;
#pragma unroll
            for (int ai = 0; ai < 2; ++ai)
#pragma unroll
                for (int bj = 0; bj < 2; ++bj)
#pragma unroll
                    for (int n = 0; n < 2; ++n) {
                        f32x4 carry = {0.f, 0.f, 0.f, 0.f};
#pragma unroll
                        for (int m = 0; m < 4; ++m) {
                            float s0, s1, s2, s3;
                            {
                                const f32x4 x = acc[ai][bj][m][n] * rs[ai][m] + bb[bj][n];
                                s0 = fminf(x[0], 0.0f) * (LOG2E / 16.0f) - __builtin_amdgcn_logf(1.0f + __builtin_amdgcn_exp2f(-fabsf(x[0]) * LOG2E)) * (1.0f / 16.0f);
                                s1 = fminf(x[1], 0.0f) * (LOG2E / 16.0f) - __builtin_amdgcn_logf(1.0f + __builtin_amdgcn_exp2f(-fabsf(x[1]) * LOG2E)) * (1.0f / 16.0f);
                                s2 = fminf(x[2], 0.0f) * (LOG2E / 16.0f) - __builtin_amdgcn_logf(1.0f + __builtin_amdgcn_exp2f(-fabsf(x[2]) * LOG2E)) * (1.0f / 16.0f);
                                s3 = fminf(x[3], 0.0f) * (LOG2E / 16.0f) - __builtin_amdgcn_logf(1.0f + __builtin_amdgcn_exp2f(-fabsf(x[3]) * LOG2E)) * (1.0f / 16.0f);
                            }
                            asm volatile("s_nop 1\n\t"
                                         "v_add_f32_dpp %0, %0, %0 row_shr:1 row_mask:0xf bank_mask:0xf bound_ctrl:0\n\tv_add_f32_dpp %1, %1, %1 row_shr:1 row_mask:0xf bank_mask:0xf bound_ctrl:0\n\t"
                                         "v_add_f32_dpp %2, %2, %2 row_shr:1 row_mask:0xf bank_mask:0xf bound_ctrl:0\n\tv_add_f32_dpp %3, %3, %3 row_shr:1 row_mask:0xf bank_mask:0xf bound_ctrl:0\n\t"
                                         "v_add_f32_dpp %0, %0, %0 row_shr:2 row_mask:0xf bank_mask:0xf bound_ctrl:0\n\tv_add_f32_dpp %1, %1, %1 row_shr:2 row_mask:0xf bank_mask:0xf bound_ctrl:0\n\t"
                                         "v_add_f32_dpp %2, %2, %2 row_shr:2 row_mask:0xf bank_mask:0xf bound_ctrl:0\n\tv_add_f32_dpp %3, %3, %3 row_shr:2 row_mask:0xf bank_mask:0xf bound_ctrl:0\n\t"
                                         "v_add_f32_dpp %0, %0, %0 row_shr:4 row_mask:0xf bank_mask:0xf bound_ctrl:0\n\tv_add_f32_dpp %1, %1, %1 row_shr:4 row_mask:0xf bank_mask:0xf bound_ctrl:0\n\t"
                                         "v_add_f32_dpp %2, %2, %2 row_shr:4 row_mask:0xf bank_mask:0xf bound_ctrl:0\n\tv_add_f32_dpp %3, %3, %3 row_shr:4 row_mask:0xf bank_mask:0xf bound_ctrl:0\n\t"
                                         "v_add_f32_dpp %0, %0, %0 row_shr:8 row_mask:0xf bank_mask:0xf bound_ctrl:0\n\tv_add_f32_dpp %1, %1, %1 row_shr:8 row_mask:0xf bank_mask:0xf bound_ctrl:0\n\t"
                                         "v_add_f32_dpp %2, %2, %2 row_shr:8 row_mask:0xf bank_mask:0xf bound_ctrl:0\n\tv_add_f32_dpp %3, %3, %3 row_shr:8 row_mask:0xf bank_mask:0xf bound_ctrl:0\n\t"
                                         "s_nop 1"
                                         : "+v"(s0), "+v"(s1), "+v"(s2), "+v"(s3));
                            const f32x4 sc = {s0, s1, s2, s3};
                            f32x4 tt;
                            tt[0] = __builtin_bit_cast(float, __builtin_amdgcn_ds_bpermute(l15, __builtin_bit_cast(int, s0))); tt[1] = __builtin_bit_cast(float, __builtin_amdgcn_ds_bpermute(l15, __builtin_bit_cast(int, s1)));
                            tt[2] = __builtin_bit_cast(float, __builtin_amdgcn_ds_bpermute(l15, __builtin_bit_cast(int, s2))); tt[3] = __builtin_bit_cast(float, __builtin_amdgcn_ds_bpermute(l15, __builtin_bit_cast(int, s3)));
                            *(f32x4*)(LA + (size_t)(row0 + ai * HALF + m * 16) * 512 + (pn - 18) * 256 + bj * HALF + colw + 4 * n) = sc + carry;
                            carry = carry + tt;
                        }
                    }
        } else {
            const int mode = pn < 14 ? 0 : (pn < 18 ? 1 : 2);
            const float post = (pn == 6 || pn == 7) ? QB_SCALE : 1.0f;
#pragma unroll
            for (int ai = 0; ai < 2; ++ai)
#pragma unroll
                for (int m = 0; m < 4; ++m) {
                    const int row = row0 + ai * HALF + m * 16;
                    const float sc = rs[ai][m] * post, sce = rs[ai][m] * -LOG2E;
                    f32x4 v[2][2];
#pragma unroll
                    for (int bj = 0; bj < 2; ++bj)
#pragma unroll
                        for (int n = 0; n < 2; ++n) {
                            if (mode == 0) v[bj][n] = acc[ai][bj][m][n] * sc;
                            else {
#pragma unroll
                                for (int i = 0; i < 4; ++i) { const float a = acc[ai][bj][m][n][i], sg = __builtin_amdgcn_rcpf(1.0f + __builtin_amdgcn_exp2f(a * sce)); v[bj][n][i] = mode == 1 ? (a * sc) * sg : sg; }
                            }
                        }
                    bf16_t* rowp = Z + (size_t)row * NZ + pn * BM + colw;
#pragma unroll
                    for (int bj = 0; bj < 2; ++bj) *(u32x4*)(rowp + bj * HALF) = pack8(v[bj][0], v[bj][1]);
                }
        }
    }
};
struct EpiMix {
    static constexpr bool PERM = true, AFTER_DRAIN = false; static __device__ __forceinline__ bool keeps_acc(const Unit& u) { return u.seg == 0; }
    bf16_t* O; const bf16_t* GA; const bf16_t* GB;
    __device__ __forceinline__ void operator()(f32x4 (&acc)[2][2][4][2], const Unit& u, int wr, int wc, int fr, int fq) const {
        const int row0 = u.pm * BM + wr * 64 + fr, col0 = u.pn * BM + wc * 32 + 8 * fq;
        if (u.seg == 0) {
#pragma unroll
            for (int ai = 0; ai < 2; ++ai)
#pragma unroll
                for (int mb = 0; mb < 4; mb += 2) {
                    u32x4 ga[2][2], gb[2][2];
#pragma unroll
                    for (int mm = 0; mm < 2; ++mm)
#pragma unroll
                        for (int bj = 0; bj < 2; ++bj) { const size_t off = (size_t)(row0 + ai * HALF + (mb + mm) * 16) * NZ + col0 + bj * HALF; ga[mm][bj] = *(const u32x4*)(GA + off); gb[mm][bj] = *(const u32x4*)(GB + off); }
#pragma unroll
                    for (int mm = 0; mm < 2; ++mm)
#pragma unroll
                        for (int bj = 0; bj < 2; ++bj) { const int m = mb + mm;
                            const f32x4 a0 = unlo(ga[mm][bj]), a1 = unhi(ga[mm][bj]), b0 = unlo(gb[mm][bj]), b1 = unhi(gb[mm][bj]);
#pragma unroll
                            for (int i = 0; i < 4; ++i) { const float t0 = __uint_as_float(cvt_pk_bf16(acc[ai][bj][m][0][i] * a0[i], 0.f) << 16), t1 = __uint_as_float(cvt_pk_bf16(acc[ai][bj][m][1][i] * a1[i], 0.f) << 16); acc[ai][bj][m][0][i] = t0 * __builtin_amdgcn_rcpf(fmaxf(b0[i], 1e-20f)); acc[ai][bj][m][1][i] = t1 * __builtin_amdgcn_rcpf(fmaxf(b1[i], 1e-20f)); } }
                }
        } else {
#pragma unroll
            for (int ai = 0; ai < 2; ++ai) {
                u32x4 gb[4][2];
#pragma unroll
                for (int m = 0; m < 4; ++m)
#pragma unroll
                    for (int bj = 0; bj < 2; ++bj) gb[m][bj] = *(const u32x4*)(GB + (size_t)(row0 + ai * HALF + m * 16) * NZ + col0 + bj * HALF);
                asm volatile("" ::: "memory");
#pragma unroll
                for (int m = 0; m < 4; ++m)
#pragma unroll
                    for (int bj = 0; bj < 2; ++bj) *(u32x4*)(O + (size_t)(row0 + ai * HALF + m * 16) * 2048 + col0 + bj * HALF) = pack8(acc[ai][bj][m][0] * unlo(gb[m][bj]), acc[ai][bj][m][1] * unhi(gb[m][bj]));
                asm volatile("" ::: "memory");
            }
        }
    }
};
struct EpiRes {
    static constexpr bool PERM = true, AFTER_DRAIN = false; static __device__ __forceinline__ bool keeps_acc(const Unit&) { return false; }
    bf16_t* xb; float* ssq;
    __device__ __forceinline__ void operator()(const f32x4 (&acc)[2][2][4][2], const Unit& u, int wr, int wc, int fr, int fq) const {
        const int row0 = u.pm * BM + wr * 64 + fr, col0 = u.pn * BM + wc * 32 + 8 * fq;
        float sqs[2][4];
#pragma unroll
        for (int ai = 0; ai < 2; ++ai) {
            u32x4 rv[4][2];
#pragma unroll
            for (int m = 0; m < 4; ++m)
#pragma unroll
                for (int bj = 0; bj < 2; ++bj) rv[m][bj] = *(const u32x4*)(xb + (size_t)(row0 + ai * HALF + m * 16) * 2048 + col0 + bj * HALF);
            asm volatile("" ::: "memory");
#pragma unroll
            for (int m = 0; m < 4; ++m) {
                const int row = row0 + ai * HALF + m * 16;
                float sq = 0.0f;
#pragma unroll
                for (int bj = 0; bj < 2; ++bj) {
                    const f32x4 x0 = unlo(rv[m][bj]) + acc[ai][bj][m][0], x1 = unhi(rv[m][bj]) + acc[ai][bj][m][1];
                    sq += ((x0[0] * x0[0] + x0[1] * x0[1]) + (x0[2] * x0[2] + x0[3] * x0[3])) + ((x1[0] * x1[0] + x1[1] * x1[1]) + (x1[2] * x1[2] + x1[3] * x1[3]));
                    *(u32x4*)(xb + (size_t)row * 2048 + col0 + bj * HALF) = pack8(x0, x1);
                }
                sq += __shfl_xor(sq, 16); sq += __shfl_xor(sq, 32);
                sqs[ai][m] = sq;
            }
            asm volatile("" ::: "memory");
        }
#pragma unroll
        for (int ai = 0; ai < 2; ++ai) { const float v = fq == 0 ? sqs[ai][0] : (fq == 1 ? sqs[ai][1] : (fq == 2 ? sqs[ai][2] : sqs[ai][3]));
            ssq[(size_t)(row0 + ai * HALF + fq * 16) * 32 + u.pn * 4 + wc] = v; }
    }
};
__device__ __forceinline__ unsigned dpp_ror1(unsigned x) { return (unsigned)__builtin_amdgcn_mov_dpp((int)x, 0x121, 0xf, 0xf, false); }
__device__ __forceinline__ unsigned dpp_ror2(unsigned x) { return (unsigned)__builtin_amdgcn_mov_dpp((int)x, 0x122, 0xf, 0xf, false); }
__device__ __forceinline__ unsigned dpp_shr1(unsigned old, unsigned x) { return (unsigned)__builtin_amdgcn_update_dpp((int)old, (int)x, 0x111, 0xf, 0xf, false); }
__device__ __forceinline__ unsigned dpp_shr2(unsigned old, unsigned x) { return (unsigned)__builtin_amdgcn_update_dpp((int)old, (int)x, 0x112, 0xf, 0xf, false); }
typedef unsigned u32x2 __attribute__((ext_vector_type(2)));
typedef _Float16 f16x2_t __attribute__((ext_vector_type(2)));
__device__ __forceinline__ unsigned cvt_pk_f16(float lo, float hi) { const f32x2_t v = {lo, hi}; const f16x2_t h = __builtin_convertvector(v, f16x2_t); return __builtin_bit_cast(unsigned, h); }
__device__ __forceinline__ f16x2_t as_h2(unsigned x) { return __builtin_bit_cast(f16x2_t, x); }
__device__ __forceinline__ unsigned h2_bits(f16x2_t x) { return __builtin_bit_cast(unsigned, x); }
constexpr float LN2 = 0.6931471805599453f;
struct EpiUp {
    static constexpr bool PERM = true, AFTER_DRAIN = false; static __device__ __forceinline__ bool keeps_acc(const Unit&) { return false; }
    bf16_t* ACT; const PG8_LAS float* rsl; PG8_LAS unsigned* xl; PG8_LAS unsigned* cwl; const float* cw; const float* cb; bf16_t* HF; bf16_t* HL;
    __device__ __forceinline__ void operator()(const f32x4 (&acc)[2][2][4][2], const Unit& u, int wr, int wc, int fr, int fq) const {
        const int pn = u.pn, row0 = u.pm * BM + wr * 64 + fr, colw = wc * 32 + 8 * fq, c0 = 128 * pn + colw;
        {
            const int t = (wr * 4 + wc) * 64 + fq * 16 + fr, kind = t >> 6, cc = 2 * (t & 63), gu = kind >> 2, j = kind & 3;
            const float* src = (j < 3 ? cw + (size_t)j * 11264 : cb) + gu * 5632 + 128 * pn + cc;
            const float sc = gu == 0 ? -LOG2E : -LN2;
            cwl[t] = cvt_pk_f16(src[0] * sc, src[1] * sc);
        }
        u32x2 hp[2][2][4][2];
#pragma unroll
        for (int ai = 0; ai < 2; ++ai)
#pragma unroll
            for (int m = 0; m < 4; ++m) { const float rs = rsl[(row0 + ai * HALF + m * 16) & 2047];
#pragma unroll
                for (int gu = 0; gu < 2; ++gu)
#pragma unroll
                    for (int n = 0; n < 2; ++n) { const f32x4 v = acc[ai][gu][m][n] * rs; hp[ai][gu][m][n].x = cvt_pk_f16(v[0], v[1]); hp[ai][gu][m][n].y = cvt_pk_f16(v[2], v[3]); } }
        if (fr >= 14) {
#pragma unroll
            for (int ai = 0; ai < 2; ++ai)
#pragma unroll
                for (int gu = 0; gu < 2; ++gu)
#pragma unroll
                    for (int n = 0; n < 2; ++n) { *(PG8_LAS u32x2*)(xl + ((((2 * ai + wr) * 2 + (fr - 14)) * 256 + 128 * gu + colw + 4 * n) >> 1)) = hp[ai][gu][3][n];
                        if (ai == 1 && wr == 1) *(u32x2*)(HL + (size_t)(u.pm * 2 + fr - 14) * 11264 + pn * 256 + 128 * gu + colw + 4 * n) = hp[1][gu][3][n]; }
        }
        if (wr == 0 && fr < 2) {
#pragma unroll
            for (int gu = 0; gu < 2; ++gu)
#pragma unroll
                for (int n = 0; n < 2; ++n) *(u32x2*)(HF + (size_t)(u.pm * 2 + fr) * 11264 + pn * 256 + 128 * gu + colw + 4 * n) = hp[0][gu][0][n];
        }
        asm volatile("s_waitcnt lgkmcnt(0)" ::: "memory"); __builtin_amdgcn_s_barrier(); asm volatile("" ::: "memory");
#pragma unroll
        for (int ai = 0; ai < 2; ++ai) {
            const bool hasp = (ai == 1) || (wr == 1); const int qp = 2 * ai + wr - 1;
#pragma unroll
            for (int m = 0; m < 4; ++m) {
                f32x4 ov[2];
#pragma unroll
                for (int n = 0; n < 2; ++n) {
                    u32x2 cv[2];
#pragma unroll
                    for (int gu = 0; gu < 2; ++gu) {
                        const PG8_LAS u32x2* cp = (const PG8_LAS u32x2*)(cwl + gu * 256 + ((colw + 4 * n) >> 1));
                        const u32x2 w0 = cp[0], w1 = cp[32], w2 = cp[64], bb = cp[96];
                        const u32x2 hc = hp[ai][gu][m][n];
                        u32x2 o1, o2;
                        if (m > 0) { const u32x2 q = hp[ai][gu][m > 0 ? m - 1 : 0][n]; o1.x = dpp_ror1(q.x); o1.y = dpp_ror1(q.y); o2.x = dpp_ror2(q.x); o2.y = dpp_ror2(q.y); }
                        else if (hasp) { const u32x2 p1 = *(const PG8_LAS u32x2*)(xl + (((qp * 2 + 1) * 256 + 128 * gu + colw + 4 * n) >> 1)), p2 = *(const PG8_LAS u32x2*)(xl + (((qp * 2 + 0) * 256 + 128 * gu + colw + 4 * n) >> 1));
                            o1 = p1; o2.x = fr == 0 ? p2.x : p1.x; o2.y = fr == 0 ? p2.y : p1.y; }
                        else { o1 = (u32x2){0u, 0u}; o2 = o1; }
                        u32x2 s1, s2; s1.x = dpp_shr1(o1.x, hc.x); s1.y = dpp_shr1(o1.y, hc.y); s2.x = dpp_shr2(o2.x, hc.x); s2.y = dpp_shr2(o2.y, hc.y);
                        cv[gu].x = h2_bits(as_h2(w0.x) * as_h2(s2.x) + (as_h2(w1.x) * as_h2(s1.x) + (as_h2(w2.x) * as_h2(hc.x) + as_h2(bb.x))));
                        cv[gu].y = h2_bits(as_h2(w0.y) * as_h2(s2.y) + (as_h2(w1.y) * as_h2(s1.y) + (as_h2(w2.y) * as_h2(hc.y) + as_h2(bb.y))));
                    }
                    const f16x2_t g0 = as_h2(cv[0].x), g1 = as_h2(cv[0].y), p0 = g0 * as_h2(cv[1].x), p1 = g1 * as_h2(cv[1].y);
                    ov[n][0] = (float)p0[0] * __builtin_amdgcn_rcpf(1.0f + __builtin_amdgcn_exp2f((float)g0[0]));
                    ov[n][1] = (float)p0[1] * __builtin_amdgcn_rcpf(1.0f + __builtin_amdgcn_exp2f((float)g0[1]));
                    ov[n][2] = (float)p1[0] * __builtin_amdgcn_rcpf(1.0f + __builtin_amdgcn_exp2f((float)g1[0]));
                    ov[n][3] = (float)p1[1] * __builtin_amdgcn_rcpf(1.0f + __builtin_amdgcn_exp2f((float)g1[1]));
                }
                *(u32x4*)(ACT + (size_t)(row0 + ai * HALF + m * 16) * 5632 + c0) = pack8(ov[0], ov[1]);
            }
        }
    }
};
template <class Epi, class Sched, bool ALIGN_EPI = false, bool SP2 = false>
__device__ __forceinline__ void gemm_phase(PG8_LAS unsigned char* lds, const Gemm g, const Sched& S, const Epi& E, const int tid) {
    const int wid = __builtin_amdgcn_readfirstlane(tid >> 6), lane = tid & 63, wr = wid >> 2, wc = wid & 3, fr = lane & 15, fq = lane >> 4;
    const int K = g.K, nt = K / BK, lda = g.lda;
    unsigned voffA[2], voffB[2];
#pragma unroll
    for (int i = 0; i < 2; ++i) { int R, C; stage_rc(tid * 16 + i * 8192, R, C); const int Rb = Epi::PERM ? ((R & ~31) + perm32(R & 31)) : R;
        voffA[i] = (unsigned)(R * lda + C) * 2u; voffB[i] = (unsigned)(Rb * K + C) * 2u; }
    const size_t kstep = (size_t)(BK * 2);
    const size_t hA = (size_t)HALF * lda * 2, hB = (size_t)HALF * K * 2;
    const size_t tA = 2 * hA, tB = 2 * hB;
    const unsigned ldsw = (unsigned)wid * 1024u;
    const int aoff = lds_byte(wr * 64 + fr, fq * 8), boff = lds_byte(wc * 32 + fr, fq * 8);
#define PG8_SA(b, h) (((b) * 2 + (h)) * HTB)
#define PG8_SB(b, h) ((4 + (b) * 2 + (h)) * HTB)
#define PG8_STAGE(bufoff, gbase, voff) do { _Pragma("unroll") for (int _i = 0; _i < 2; ++_i) \
        __builtin_amdgcn_global_load_lds((const unsigned*)((const char*)(gbase) + (voff)[_i]), (PG8_LAS unsigned*)(lds + (bufoff) + ldsw + _i * 8192), 16, 0, 0); } while (0)
#define PG8_LDA(dst, b, h) do { _Pragma("unroll") for (int m = 0; m < 4; ++m) _Pragma("unroll") for (int k = 0; k < 2; ++k) dst[m][k] = *(const PG8_LAS bf16x8*)(lds + PG8_SA(b, h) + aoff + m * 2048 + k * 1024); } while (0)
#define PG8_LDB(dst, b, h) do { _Pragma("unroll") for (int n = 0; n < 2; ++n) _Pragma("unroll") for (int k = 0; k < 2; ++k) dst[n][k] = *(const PG8_LAS bf16x8*)(lds + PG8_SB(b, h) + boff + n * 2048 + k * 1024); } while (0)
#define PG8_MMA(ai, bj, At, Bt) do { __builtin_amdgcn_s_setprio(1); _Pragma("unroll") for (int m = 0; m < 4; ++m) _Pragma("unroll") for (int n = 0; n < 2; ++n) _Pragma("unroll") for (int k = 0; k < 2; ++k) \
        acc[ai][bj][m][n] = __builtin_amdgcn_mfma_f32_16x16x32_bf16(Bt[n][k], At[m][k], acc[ai][bj][m][n], 0, 0, 0); __builtin_amdgcn_s_setprio(0); } while (0)
#define PG8_WAIT_V(n) asm volatile("s_waitcnt vmcnt(" #n ")" ::: "memory")
#define PG8_WAIT_L(n) asm volatile("s_waitcnt lgkmcnt(" #n ")" ::: "memory")
#define PG8_BAR __builtin_amdgcn_s_barrier()
#define PG8_SCHED __builtin_amdgcn_sched_barrier(0)
    Unit cur, nxt; int ui = 0;
    if (!S.next(0, cur)) return;
    f32x4 acc[2][2][4][2];
#pragma unroll
    for (int a = 0; a < 2; ++a)
#pragma unroll
        for (int b = 0; b < 2; ++b)
#pragma unroll
            for (int m = 0; m < 4; ++m)
#pragma unroll
                for (int n = 0; n < 2; ++n) acc[a][b][m][n] = (f32x4){0.f, 0.f, 0.f, 0.f};
    bf16x8 At[4][2], B0[2][2], B1[2][2];
    const char* cA = (const char*)(cur.seg ? g.A1 : g.A) + (size_t)cur.pm * tA; const char* cB = (const char*)(cur.seg ? g.Bt1 : g.Bt) + (size_t)cur.pn * tB;
    S.a_ready(cur);
    if constexpr (SP2) {
        PG8_STAGE(PG8_SB(0, 0), cB, voffB); PG8_STAGE(PG8_SB(0, 1), cB + hB, voffB); PG8_STAGE(PG8_SA(0, 0), cA, voffA); PG8_STAGE(PG8_SA(0, 1), cA + hA, voffA);
        if (wr == 1) PG8_BAR;
        PG8_WAIT_V(2); PG8_BAR;
        PG8_STAGE(PG8_SB(1, 0), cB + kstep, voffB); PG8_STAGE(PG8_SA(1, 0), cA + kstep, voffA); PG8_STAGE(PG8_SB(1, 1), cB + hB + kstep, voffB);
        PG8_WAIT_V(6); PG8_BAR;
    } else {
        PG8_STAGE(PG8_SB(0, 0), cB, voffB); PG8_STAGE(PG8_SA(0, 0), cA, voffA); PG8_STAGE(PG8_SB(0, 1), cB + hB, voffB); PG8_STAGE(PG8_SA(0, 1), cA + hA, voffA);
        if (wr == 1) PG8_BAR;
        PG8_WAIT_V(4); PG8_BAR;
        PG8_STAGE(PG8_SB(1, 0), cB + kstep, voffB); PG8_STAGE(PG8_SA(1, 0), cA + kstep, voffA); PG8_STAGE(PG8_SB(1, 1), cB + hB + kstep, voffB);
        PG8_WAIT_V(6); PG8_BAR;
    }
    for (;;) {
        const bool has_next = S.next(ui + 1, nxt);
        const char* nA = has_next ? (const char*)(nxt.seg ? g.A1 : g.A) + (size_t)nxt.pm * tA : cA; const char* nB = has_next ? (const char*)(nxt.seg ? g.Bt1 : g.Bt) + (size_t)nxt.pn * tB : cB;
        for (int t = 0; t < nt; t += 2) {
            const bool last = (t == nt - 2);
            const char* a1 = cA + (size_t)(t + 1) * kstep;
            const char* a2 = last ? nA : cA + (size_t)(t + 2) * kstep; const char* b2 = last ? nB : cB + (size_t)(t + 2) * kstep;
            const char* a3 = a2 + kstep; const char* b3 = b2 + kstep;
            if (last && has_next) S.a_ready(nxt);
            if constexpr (SP2) {
            PG8_LDB(B0, 0, 0); PG8_LDB(B1, 0, 1); PG8_SCHED; PG8_LDA(At, 0, 0); PG8_STAGE(PG8_SA(1, 1), a1 + hA, voffA);
            PG8_WAIT_V(8); PG8_WAIT_L(0); PG8_BAR; PG8_MMA(0, 0, At, B0); PG8_MMA(0, 1, At, B1); PG8_BAR; PG8_SCHED;
            PG8_LDA(At, 0, 1); PG8_STAGE(PG8_SB(0, 0), b2, voffB); PG8_STAGE(PG8_SB(0, 1), b2 + hB, voffB); PG8_STAGE(PG8_SA(0, 0), a2, voffA);
            PG8_WAIT_V(8); PG8_WAIT_L(0); PG8_BAR; PG8_MMA(1, 0, At, B0); PG8_MMA(1, 1, At, B1); PG8_BAR; PG8_SCHED;
            PG8_LDB(B0, 1, 0); PG8_LDB(B1, 1, 1); PG8_SCHED; PG8_LDA(At, 1, 0); PG8_STAGE(PG8_SA(0, 1), a2 + hA, voffA);
            PG8_WAIT_V(8); PG8_WAIT_L(0); PG8_BAR; PG8_MMA(0, 0, At, B0); PG8_MMA(0, 1, At, B1); PG8_BAR; PG8_SCHED;
            PG8_LDA(At, 1, 1); PG8_STAGE(PG8_SB(1, 0), b3, voffB); PG8_STAGE(PG8_SB(1, 1), b3 + hB, voffB); PG8_STAGE(PG8_SA(1, 0), a3, voffA);
            PG8_WAIT_V(8); PG8_WAIT_L(0); PG8_BAR; PG8_MMA(1, 0, At, B0); PG8_MMA(1, 1, At, B1); PG8_BAR; PG8_SCHED;
            } else {
            PG8_LDB(B0, 0, 0); PG8_SCHED; PG8_LDA(At, 0, 0); PG8_STAGE(PG8_SA(1, 1), a1 + hA, voffA);
            PG8_WAIT_L(8); PG8_BAR; PG8_WAIT_L(0); PG8_MMA(0, 0, At, B0); PG8_BAR; PG8_SCHED;
            PG8_LDB(B1, 0, 1); PG8_STAGE(PG8_SB(0, 0), b2, voffB);
            PG8_BAR; PG8_WAIT_L(0); PG8_MMA(0, 1, At, B1); PG8_BAR;
            PG8_LDA(At, 0, 1); PG8_STAGE(PG8_SA(0, 0), a2, voffA);
            PG8_BAR; PG8_WAIT_L(0); PG8_MMA(1, 0, At, B0); PG8_BAR; PG8_SCHED;
            PG8_STAGE(PG8_SB(0, 1), b2 + hB, voffB);
            PG8_WAIT_V(6); PG8_BAR; PG8_MMA(1, 1, At, B1); PG8_BAR;
            PG8_LDB(B0, 1, 0); PG8_SCHED; PG8_LDA(At, 1, 0); PG8_STAGE(PG8_SA(0, 1), a2 + hA, voffA);
            PG8_WAIT_L(8); PG8_BAR; PG8_WAIT_L(0); PG8_MMA(0, 0, At, B0); PG8_BAR; PG8_SCHED;
            PG8_LDB(B1, 1, 1); PG8_STAGE(PG8_SB(1, 0), b3, voffB);
            PG8_BAR; PG8_WAIT_L(0); PG8_MMA(0, 1, At, B1); PG8_BAR;
            PG8_LDA(At, 1, 1); PG8_STAGE(PG8_SA(1, 0), a3, voffA);
            PG8_BAR; PG8_WAIT_L(0); PG8_MMA(1, 0, At, B0); PG8_BAR; PG8_SCHED;
            PG8_STAGE(PG8_SB(1, 1), b3 + hB, voffB);
            PG8_WAIT_V(6); PG8_BAR; PG8_MMA(1, 1, At, B1); PG8_BAR;
            }
        }
        if constexpr (ALIGN_EPI) { if (wr == 0) PG8_BAR; }
        if constexpr (!Epi::AFTER_DRAIN) { E(acc, cur, wr, wc, fr, fq); S.done(cur); }
        if (!has_next) break;
        if (!Epi::keeps_acc(cur)) {
#pragma unroll
        for (int a = 0; a < 2; ++a)
#pragma unroll
            for (int b = 0; b < 2; ++b)
#pragma unroll
                for (int m = 0; m < 4; ++m)
#pragma unroll
                    for (int n = 0; n < 2; ++n) acc[a][b][m][n] = (f32x4){0.f, 0.f, 0.f, 0.f};
        }
        cur = nxt; cA = nA; cB = nB; ++ui;
        if constexpr (ALIGN_EPI) { if (wr == 1) PG8_BAR; }
    }
    PG8_WAIT_V(0);
    if constexpr (!ALIGN_EPI) { if (wr == 0) PG8_BAR; }
    PG8_BAR;
    if constexpr (Epi::AFTER_DRAIN) { E.fused(acc, cur, wr, wc, fr, fq, lds, wid, lane); S.done(cur); }
#undef PG8_SA
#undef PG8_SB
#undef PG8_STAGE
#undef PG8_LDA
#undef PG8_LDB
#undef PG8_MMA
#undef PG8_WAIT_V
#undef PG8_WAIT_L
#undef PG8_BAR
#undef PG8_SCHED
}
}
#define GAS __attribute__((address_space(1)))
#define LAS __attribute__((address_space(3)))
typedef unsigned short bf16;
typedef unsigned v4u __attribute__((ext_vector_type(4)));
typedef float f32x4 __attribute__((ext_vector_type(4)));
typedef short bf16x8 __attribute__((ext_vector_type(8)));
typedef GAS unsigned gu32;
typedef GAS unsigned long long gu64;
#define RLX_AGENT __ATOMIC_RELAXED, __HIP_MEMORY_SCOPE_AGENT
#define LDS_WAIT() asm volatile("s_waitcnt lgkmcnt(0)" ::: "memory")
#define VM_WAIT() asm volatile("s_waitcnt vmcnt(0)" ::: "memory")
__device__ __forceinline__ unsigned long long rt() { return __builtin_amdgcn_s_memrealtime(); }
__device__ __forceinline__ unsigned f2bf(float f) { unsigned u = __builtin_bit_cast(unsigned, f); return (u + 0x7fffu + ((u >> 16) & 1u)) >> 16; }
__device__ __forceinline__ unsigned pk2(float lo, float hi) { return f2bf(lo) | (f2bf(hi) << 16); }

#define XB_TMO      128
#define XB_XCNT(j)  (256  + 64 * (j))
#define XB_XSUB(j)  (1280 + 64 * (j))
#define XB_XGEN(j)  (2304 + 64 * (j))
#define XB_TOP      3328
#define XB_TOPGEN   3392
#define XCD_BAR_WORDS 3456
#define XB_SPIN_CAP (1u << 18)

__device__ __forceinline__ unsigned xb_ld(unsigned* p)              { return __hip_atomic_load(p, __ATOMIC_RELAXED, __HIP_MEMORY_SCOPE_AGENT); }
__device__ __forceinline__ unsigned xb_add(unsigned* p, unsigned v) { return __hip_atomic_fetch_add(p, v, __ATOMIC_RELAXED, __HIP_MEMORY_SCOPE_AGENT); }
__device__ __forceinline__ unsigned xb_xcc_id() { return (unsigned)__builtin_amdgcn_s_getreg((3 << 11) | 20) & 0xFu; }
#define XB_SPIN(cond, bar) do { unsigned _sp = 0; while (cond) { __builtin_amdgcn_s_sleep(1); \
    if ((++_sp & 255u) == 0u) { if (xb_ld(&(bar)[XB_TMO])) break; if (_sp > XB_SPIN_CAP) { atomicAdd(&(bar)[XB_TMO], 1u); break; } } } } while (0)

struct XcdBarrier {
    unsigned* bar; unsigned x;
    volatile LAS unsigned* st;
};

__device__ __forceinline__ XcdBarrier xcd_barrier_post(unsigned* bar, volatile LAS unsigned* st) {
    XcdBarrier b; b.bar = bar; b.x = xb_xcc_id(); b.st = st;
    if (threadIdx.x == 0) (void)xb_add(&bar[XB_XCNT(b.x)], 1u);
    return b;
}
__device__ __forceinline__ void xcd_barrier_complete(unsigned* bar, unsigned x, unsigned& nloc, unsigned& nx) {
    const unsigned G = gridDim.x * gridDim.y * gridDim.z;
    unsigned sum, cnt, mine, sp = 0u;
    for (;;) {
        sum = 0u; cnt = 0u; mine = 0u;
#pragma unroll
        for (unsigned j = 0; j < 16; ++j) { const unsigned c = xb_ld(&bar[XB_XCNT(j)]); sum += c; cnt += (c > 0u) ? 1u : 0u; mine = (j == x) ? c : mine; }
        if (sum == G) break;
        __builtin_amdgcn_s_sleep(1);
        if ((++sp & 255u) == 0u) { if (xb_ld(&bar[XB_TMO])) break; if (sp > XB_SPIN_CAP) { atomicAdd(&bar[XB_TMO], 1u); break; } }
    }
    nloc = mine > 0u ? mine : 1u; nx = cnt > 0u ? cnt : 1u;
}

__device__ __forceinline__ void xcd_barrier(const XcdBarrier& b) {
    asm volatile("s_waitcnt vmcnt(0)" ::: "memory");
    __syncthreads();
    if (threadIdx.x == 0) {
        unsigned* bar = b.bar;
        __builtin_amdgcn_s_waitcnt(0);
        unsigned nloc = b.st[0], nx = b.st[1];
        if (nloc == 0u) { xcd_barrier_complete(bar, b.x, nloc, nx); b.st[0] = nloc; b.st[1] = nx; }
        const unsigned old = xb_add(&bar[XB_XSUB(b.x)], 1u);
        const unsigned gen = old / nloc;
        if (old + 1u == (gen + 1u) * nloc) {
            __builtin_amdgcn_fence(__ATOMIC_RELEASE, "agent");
            asm volatile("s_waitcnt vmcnt(0)" ::: "memory");
            const unsigned og = xb_add(&bar[XB_TOP], 1u);
            const unsigned tg = og / nx;
            if (og + 1u == (tg + 1u) * nx) xb_add(&bar[XB_TOPGEN], 1u);
            else XB_SPIN(xb_ld(&bar[XB_TOPGEN]) == tg, bar);
            __builtin_amdgcn_fence(__ATOMIC_ACQUIRE, "agent");
            xb_add(&bar[XB_XGEN(b.x)], 1u);
            asm volatile("s_waitcnt vmcnt(0)" ::: "memory");
        } else {
            XB_SPIN(xb_ld(&bar[XB_XGEN(b.x)]) == gen, bar);
            __builtin_amdgcn_fence(__ATOMIC_ACQUIRE, "agent");
            asm volatile("s_waitcnt vmcnt(0)" ::: "memory");
        }
    }
    __syncthreads();
}
typedef unsigned v2u __attribute__((ext_vector_type(2)));
typedef float v2f __attribute__((ext_vector_type(2)));

constexpr int NWAVES = 8;
constexpr int M = 16384, DM = 2048, SEQ = 2048, DFF = 5632, NH = 11264, WIN_LD = 8720;
using pg8::NZ; using pg8::ZQA; using pg8::ZKA; using pg8::ZVA; using pg8::ZQB; using pg8::ZKB; using pg8::ZVB; using pg8::ZRB; using pg8::ZAL; using pg8::ZGA; using pg8::ZGB;
constexpr int N_PHASES = 19;
constexpr size_t MiB = 1u << 20;
constexpr size_t WS_CTL = 0, CTL_ZERO_BYTES = 1 * MiB;
constexpr size_t WS_SSQ = 1 * MiB;
constexpr size_t WS_ROPE = 3 * MiB;
constexpr size_t WS_ONES = 4 * MiB;
constexpr size_t WS_WUP = 8 * MiB;
constexpr size_t WS_WDN = 52 * MiB;
constexpr size_t WS_XB = 74 * MiB;
constexpr size_t WS_WIN = 138 * MiB;
constexpr size_t WS_WA = 174 * MiB, WS_WB = 178 * MiB;
constexpr size_t WS_WO = 182 * MiB;
constexpr size_t WS_ZB = 190 * MiB;
constexpr size_t WS_LA = 478 * MiB;
constexpr size_t WS_Y = 510 * MiB;
constexpr size_t WS_MIX = 574 * MiB;
constexpr size_t WS_HF = 190 * MiB, WS_HL = 198 * MiB;
constexpr size_t WS_ACT = 490 * MiB;
constexpr size_t WS_END = 666 * MiB;
static_assert(WS_HL + (size_t)64 * 2 * NH * 4 <= WS_ACT && WS_ACT + (size_t)M * DFF * 2 <= WS_END && WS_MIX + (size_t)M * DM * 2 <= WS_END && WS_ZB + (size_t)M * NZ * 2 <= WS_LA, "ws map");
constexpr int CW_BAR = 4096;
constexpr int RING_OFF = 0, RING_BYTES = 131072;
constexpr int LDSCTL_OFF = RING_BYTES, MISC_OFF = LDSCTL_OFF + 320;
constexpr int RSTAB_OFF = LDSCTL_OFF + 1024;
constexpr int XL_OFF = RSTAB_OFF + 8192;
constexpr int CWL_OFF = XL_OFF + 8192;
constexpr int LDS_BYTES = 163840;
static_assert(CWL_OFF + 4096 <= LDS_BYTES, "LDS map");

__device__ __forceinline__ float wave_sum(float v) {
#pragma unroll
    for (int o = 1; o < 64; o <<= 1) v += __shfl_xor(v, o);
    return v;
}
__device__ __forceinline__ float wave_max(float v) {
#pragma unroll
    for (int o = 1; o < 64; o <<= 1) v = fmaxf(v, __shfl_xor(v, o));
    return v;
}
__device__ __forceinline__ float bf2f(bf16 b) { return __uint_as_float(((unsigned)b) << 16); }
__device__ __forceinline__ float bflo(unsigned w) { return __uint_as_float(w << 16); }
__device__ __forceinline__ float bfhi(unsigned w) { return __uint_as_float(w & 0xffff0000u); }
__device__ __forceinline__ void un8h(v4u w, float (&f)[8]) { const pg8::f16x2_t a = pg8::as_h2(w.x), b = pg8::as_h2(w.y), c = pg8::as_h2(w.z), d = pg8::as_h2(w.w); f[0] = (float)a[0]; f[1] = (float)a[1]; f[2] = (float)b[0]; f[3] = (float)b[1]; f[4] = (float)c[0]; f[5] = (float)c[1]; f[6] = (float)d[0]; f[7] = (float)d[1]; }
__device__ __forceinline__ void un8(v4u w, float (&f)[8]) { f[0] = bflo(w.x); f[1] = bfhi(w.x); f[2] = bflo(w.y); f[3] = bfhi(w.y); f[4] = bflo(w.z); f[5] = bfhi(w.z); f[6] = bflo(w.w); f[7] = bfhi(w.w); }
using pg8::cvt_pk_bf16;
__device__ const double ROPE_INVF[8] = {1.0, 0.19392274474868576, 0.03760603093086393, 0.007292664737217109, 0.001414213562373095, 0.0002742481756762073, 5.318295896944988e-05, 1.031338537721246e-05};

__device__ __forceinline__ void alpha_item(const float* Win, const float* Wau, const float* gk, int k0, int j0, bf16* WT, LAS float* scr, int lane) {
    const int jj = lane & 31;
    float wa[16];
#pragma unroll
    for (int r = 0; r < 16; ++r) wa[r] = Wau[r * 512 + j0 + jj];
#pragma unroll 4
    for (int i = 0; i < 32; ++i) { const int kk = 2 * i + (lane >> 5); const float* wr = Win + (size_t)(k0 + kk) * WIN_LD + 4608; float s = 0.f;
#pragma unroll
        for (int r = 0; r < 16; ++r) s += wr[r] * wa[r];
        scr[kk * 33 + jj] = s * gk[k0 + kk]; }
    LDS_WAIT(); asm volatile("" ::: "memory");
    const int c = lane & 7;
#pragma unroll
    for (int j = 0; j < 4; ++j) { const int n = (lane >> 3) + 8 * j; const LAS float* s = scr + (8 * c) * 33 + n;
        v4u o; o.x = cvt_pk_bf16(s[0 * 33], s[1 * 33]); o.y = cvt_pk_bf16(s[2 * 33], s[3 * 33]); o.z = cvt_pk_bf16(s[4 * 33], s[5 * 33]); o.w = cvt_pk_bf16(s[6 * 33], s[7 * 33]);
        *(GAS v4u*)(WT + (size_t)(ZAL + j0 + n) * DM + k0 + 8 * c) = o; }
    LDS_WAIT(); asm volatile("" ::: "memory");
}


__device__ __forceinline__ void fill_rstd_table(const float* ssq, LAS unsigned char* lds, int tid) {
    const int base = 2048 * ((int)blockIdx.x & 7);
#pragma unroll
    for (int i = 0; i < 4; ++i) { const int r = tid + 512 * i; const GAS f32x4* p = (const GAS f32x4*)(ssq + (size_t)(base + r) * 32);
        f32x4 a = p[0];
#pragma unroll
        for (int q = 1; q < 8; ++q) a = a + p[q];
        ((LAS float*)(lds + RSTAB_OFF))[r] = 1.0f / sqrtf(((a[0] + a[1]) + (a[2] + a[3])) * (1.0f / 2048.0f) + pg8::RMS_EPS); }
    __syncthreads();
}

struct Args { const void* in[17]; float* out; unsigned char* ws; int ph_lo, ph_hi; };
typedef const __attribute__((address_space(4))) Args* ArgsK;
struct LayerIn { const float *gmix, *win, *sink, *wau, *balpha, *ggla, *wa, *wb, *wo, *gffn, *wup, *cw, *cb, *wdn; };

struct TItem { const float* src; const float* gk; bf16* dst; int ldw, ldt; };
constexpr int I_IN = 272 * 32, I_A = 64 * 16, I_O = 64 * 32, I_UP = 352 * 32, I_DN = 64 * 88, I_AL = 16 * 32;
constexpr int NS_ITEMS = 2 * I_A + I_O + I_UP + I_DN;
__device__ __forceinline__ TItem decode_win(const float* win, const float* gmix, unsigned char* ws, int r) {
    TItem t; const int kb = r / 272, nb = r % 272; const int n0 = nb < 144 ? nb * 32 : 5120 + (nb - 144) * 32; const int c0 = n0 < 4608 ? n0 : n0 - 496;
    t.src = win + (size_t)(kb * 64) * WIN_LD + c0; t.gk = gmix + kb * 64; t.dst = (bf16*)(ws + WS_WIN) + (size_t)n0 * DM + kb * 64; t.ldw = WIN_LD; t.ldt = DM; return t;
}
__device__ __forceinline__ TItem decode_side(const LayerIn& L, unsigned char* ws, int it) {
    TItem t; int r = it;
    if (r < I_A) { const int kb = r / 64, nb = r % 64; t.src = L.wa + (size_t)(kb * 64) * DM + nb * 32; t.gk = nullptr; t.dst = (bf16*)(ws + WS_WA) + (size_t)(nb * 32) * 1024 + kb * 64; t.ldw = DM; t.ldt = 1024; return t; } r -= I_A;
    if (r < I_A) { const int kb = r / 64, nb = r % 64; t.src = L.wb + (size_t)(kb * 64) * DM + nb * 32; t.gk = nullptr; t.dst = (bf16*)(ws + WS_WB) + (size_t)(nb * 32) * 1024 + kb * 64; t.ldw = DM; t.ldt = 1024; return t; } r -= I_A;
    if (r < I_O) { const int kb = r / 64, nb = r % 64; t.src = L.wo + (size_t)(kb * 64) * DM + nb * 32; t.gk = nullptr; t.dst = (bf16*)(ws + WS_WO) + (size_t)(nb * 32) * DM + kb * 64; t.ldw = DM; t.ldt = DM; return t; } r -= I_O;
    if (r < I_UP) { const int kb = r / 352, nb = r % 352; const int n0 = nb * 32, pn = n0 >> 8, j0 = n0 & 255; const int c0 = j0 < 128 ? 128 * pn + j0 : DFF + 128 * pn + (j0 - 128);
        t.src = L.wup + (size_t)(kb * 64) * NH + c0; t.gk = L.gffn + kb * 64; t.dst = (bf16*)(ws + WS_WUP) + (size_t)n0 * DM + kb * 64; t.ldw = NH; t.ldt = DM; return t; } r -= I_UP;
    { const int kb = r / 64, nb = r % 64; t.src = L.wdn + (size_t)(kb * 64) * DM + nb * 32; t.gk = nullptr; t.dst = (bf16*)(ws + WS_WDN) + (size_t)(nb * 32) * DFF + kb * 64; t.ldw = DM; t.ldt = DFF; return t; }
}
struct SideJob { ArgsK ap; int l; };
__device__ __forceinline__ TItem decode_job(const SideJob& J, unsigned char* ws, int it) {
    const int l = J.l;
    if (it >= NS_ITEMS) return decode_win((const float*)J.ap->in[3] + (size_t)DM * WIN_LD, (const float*)J.ap->in[2] + DM, ws, it - NS_ITEMS);
    LayerIn L;
    L.wa = (const float*)J.ap->in[8] + (size_t)l * 1024 * DM; L.wb = (const float*)J.ap->in[9] + (size_t)l * 1024 * DM; L.wo = (const float*)J.ap->in[10] + (size_t)l * DM * DM;
    L.gffn = (const float*)J.ap->in[11] + (size_t)l * DM; L.wup = (const float*)J.ap->in[12] + (size_t)l * DM * NH; L.wdn = (const float*)J.ap->in[15] + (size_t)l * DFF * DM;
    return decode_side(L, ws, it);
}
__device__ __forceinline__ void titem_load(const TItem& t, int lane, float (&v)[32], f32x4 (&g)[2]) {
    const float* p = t.src + (size_t)(lane >> 5) * t.ldw + (lane & 31);
#pragma unroll
    for (int i = 0; i < 32; ++i) v[i] = p[(size_t)(2 * i) * t.ldw];
    if (t.gk) { g[0] = *(const GAS f32x4*)(t.gk + 8 * (lane & 7)); g[1] = *(const GAS f32x4*)(t.gk + 8 * (lane & 7) + 4); }
    else { g[0] = (f32x4){1.f, 1.f, 1.f, 1.f}; g[1] = g[0]; }
}
__device__ __forceinline__ void titem_store(const TItem& t, int lane, const float (&v)[32], const f32x4 (&g)[2], LAS float* scr) {
#pragma unroll
    for (int i = 0; i < 32; ++i) scr[(2 * i + (lane >> 5)) * 33 + (lane & 31)] = v[i];
    LDS_WAIT(); asm volatile("" ::: "memory");
    const int c = lane & 7;
#pragma unroll
    for (int j = 0; j < 4; ++j) { const int n = (lane >> 3) + 8 * j; const LAS float* s = scr + (8 * c) * 33 + n;
        v4u o; o.x = cvt_pk_bf16(s[0 * 33] * g[0][0], s[1 * 33] * g[0][1]); o.y = cvt_pk_bf16(s[2 * 33] * g[0][2], s[3 * 33] * g[0][3]); o.z = cvt_pk_bf16(s[4 * 33] * g[1][0], s[5 * 33] * g[1][1]); o.w = cvt_pk_bf16(s[6 * 33] * g[1][2], s[7 * 33] * g[1][3]);
        *(GAS v4u*)(t.dst + (size_t)n * t.ldt + 8 * c) = o; }
    LDS_WAIT(); asm volatile("" ::: "memory");
}
__device__ __forceinline__ void phase_weights(const LayerIn& L, unsigned char* ws, LAS unsigned char* lds, int gw, int NGW, int wave, int lane) {
    LAS float* scr = (LAS float*)(lds + RING_OFF + wave * 16384);
    float vA[32], vB[32]; f32x4 gA[2], gB[2]; TItem dA, dB;
    int it = gw;
    if (it < I_IN) { dA = decode_win(L.win, L.gmix, ws, it); titem_load(dA, lane, vA, gA); }
    while (it < I_IN) {
        const int it2 = it + NGW, it3 = it2 + NGW;
        if (it2 < I_IN) { dB = decode_win(L.win, L.gmix, ws, it2); titem_load(dB, lane, vB, gB); }
        titem_store(dA, lane, vA, gA, scr);
        if (it3 < I_IN) { dA = decode_win(L.win, L.gmix, ws, it3); titem_load(dA, lane, vA, gA); }
        if (it2 < I_IN) titem_store(dB, lane, vB, gB, scr);
        it = it3;
    }
    for (int r = gw; r < I_AL; r += NGW) { const int kb = r / 16, jb = r % 16; alpha_item(L.win, L.wau, L.gmix, kb * 64, jb * 32, (bf16*)(ws + WS_WIN), scr, lane); }
}
__device__ __forceinline__ void phase_xprep(const float* x, const int* pos, unsigned char* ws, int gw, int NGW, int lane) {
    bf16* XB = (bf16*)(ws + WS_XB); float* SSQ = (float*)(ws + WS_SSQ); float* CS = (float*)(ws + WS_ROPE);
    if (gw == 0) ((float*)(ws + WS_ONES))[lane] = 1.0f;
    for (int m0 = gw * 2; m0 < M; m0 += NGW * 2) {
        f32x4 v[2][8]; float s[2] = {0.f, 0.f};
#pragma unroll
        for (int k = 0; k < 2; ++k) { const GAS f32x4* xr = (const GAS f32x4*)(x + (size_t)(m0 + k) * DM) + lane;
#pragma unroll
            for (int j = 0; j < 8; ++j) { v[k][j] = xr[64 * j]; s[k] += (v[k][j].x * v[k][j].x + v[k][j].y * v[k][j].y) + (v[k][j].z * v[k][j].z + v[k][j].w * v[k][j].w); } }
#pragma unroll
        for (int off = 1; off < 64; off <<= 1) { s[0] += __shfl_xor(s[0], off); s[1] += __shfl_xor(s[1], off); }
#pragma unroll
        for (int k = 0; k < 2; ++k) { const int m = m0 + k;
            GAS v2u* o8 = (GAS v2u*)(XB + (size_t)m * DM) + lane;
#pragma unroll
            for (int j = 0; j < 8; ++j) { v2u w; w.x = cvt_pk_bf16(v[k][j].x, v[k][j].y); w.y = cvt_pk_bf16(v[k][j].z, v[k][j].w); o8[64 * j] = w; }
            if (lane < 32) SSQ[(size_t)m * 32 + lane] = lane == 0 ? s[k] : 0.f;
            if (lane < 8) {
                const double a = (double)pos[m] * ROPE_INVF[lane] * 0.15915494309189535; const float fr = (float)(a - rint(a));
                v2f cs2; cs2.x = __builtin_amdgcn_cosf(fr); cs2.y = __builtin_amdgcn_sinf(fr); *(GAS v2f*)(CS + (size_t)m * 16 + 2 * lane) = cs2; } }
    }
}

typedef float f32x16 __attribute__((ext_vector_type(16)));
typedef short s16x4 __attribute__((ext_vector_type(4)));
constexpr int SW_PITCH = 144, SW_KOFF = 0, SW_VOFF = 256 * SW_PITCH;
__device__ __forceinline__ s16x4 lds_tr(LAS const unsigned char* p) { return __builtin_bit_cast(s16x4, __builtin_amdgcn_ds_read_tr16_b64_v4i16((LAS s16x4*)p)); }
__device__ __forceinline__ bf16x8 mk8(s16x4 lo, s16x4 hi) { return (bf16x8){lo[0], lo[1], lo[2], lo[3], hi[0], hi[1], hi[2], hi[3]}; }
__device__ __forceinline__ void swa_phase(const bf16* Z, const float* sink, bf16* Y, LAS unsigned char* lds, int tid0, int G) {
    const int wave = __builtin_amdgcn_readfirstlane(tid0 >> 6);
    for (int it = blockIdx.x; it < 512; it += G) {
        int tid = tid0; asm volatile("" : "+v"(tid));
        const int lane = tid & 63, r32 = lane & 31, hh = lane >> 5;
        const int tq = (lane & 15) >> 2, tp = lane & 3, tcb = 16 * ((lane >> 4) & 1);
        const int b = it >> 6, blk = (it >> 2) & 15, hk = it & 3;
        const int r0 = b * SEQ + blk * 128 - 128;
        v4u kv[4], vv[4];
#pragma unroll
        for (int i = 0; i < 4; ++i) { const int c = tid + 512 * i, ki = c >> 3, dc = c & 7;
            if (blk > 0 || ki >= 128) { const bf16* src = Z + (size_t)(r0 + ki) * NZ + hk * 64 + dc * 8; kv[i] = *(const GAS v4u*)(src + ZKA); vv[i] = *(const GAS v4u*)(src + ZVA); }
            else { kv[i] = (v4u){0u, 0u, 0u, 0u}; vv[i] = (v4u){0u, 0u, 0u, 0u}; } }
#pragma unroll
        for (int i = 0; i < 4; ++i) { const int c = tid + 512 * i, ki = c >> 3, dc = c & 7;
            *(LAS v4u*)(lds + SW_KOFF + ki * SW_PITCH + dc * 16) = kv[i]; *(LAS v4u*)(lds + SW_VOFF + ki * SW_PITCH + dc * 16) = vv[i]; }
        __syncthreads();
        const int hq = 4 * hk + (wave >> 1);
        const float sk = sink[hq] * pg8::LOG2E;
#pragma nounroll
        for (int qs = 0; qs < 2; ++qs) {
            const int a = 2 * (wave & 1) + qs, q0 = 32 * a;
            const size_t rowq = (size_t)b * SEQ + blk * 128 + q0 + r32;
            bf16x8 qf[4];
#pragma unroll
            for (int s = 0; s < 4; ++s) qf[s] = *(const GAS bf16x8*)(Z + rowq * NZ + ZQA + hq * 64 + 16 * s + 8 * hh);
            f32x16 sc[5];
#pragma unroll
            for (int j = 0; j < 5; ++j) {
                f32x16 acc = {0.f, 0.f, 0.f, 0.f, 0.f, 0.f, 0.f, 0.f, 0.f, 0.f, 0.f, 0.f, 0.f, 0.f, 0.f, 0.f};
                const LAS unsigned char* kp = lds + SW_KOFF + (32 * (a + j) + r32) * SW_PITCH + 16 * hh;
#pragma unroll
                for (int s = 0; s < 4; ++s) acc = __builtin_amdgcn_mfma_f32_32x32x16_bf16(*(const LAS bf16x8*)(kp + 32 * s), qf[s], acc, 0, 0, 0);
                sc[j] = acc;
            }
            const int qi = q0 + r32;
            float mx = -INFINITY;
#pragma unroll
            for (int j = 0; j < 5; ++j)
#pragma unroll
                for (int rho = 0; rho < 16; ++rho) { const int key = 32 * (a + j) + (rho & 3) + 8 * (rho >> 2) + 4 * hh;
                    const bool ok = (key > qi) && (key <= qi + 128) && (blk > 0 || key >= 128);
                    const float v = ok ? sc[j][rho] : -INFINITY; sc[j][rho] = v; mx = fmaxf(mx, v); }
            mx = fmaxf(mx, __shfl_xor(mx, 32)); mx = fmaxf(mx, sk);
            float ls = 0.f;
#pragma unroll
            for (int j = 0; j < 5; ++j)
#pragma unroll
                for (int rho = 0; rho < 16; ++rho) { const float p = __builtin_amdgcn_exp2f(sc[j][rho] - mx); sc[j][rho] = p; ls += p; }
            ls += __shfl_xor(ls, 32); ls += __builtin_amdgcn_exp2f(sk - mx);
            const float rinv = 1.0f / ls;
            f32x16 oa[2];
            oa[0] = (f32x16){0.f, 0.f, 0.f, 0.f, 0.f, 0.f, 0.f, 0.f, 0.f, 0.f, 0.f, 0.f, 0.f, 0.f, 0.f, 0.f}; oa[1] = oa[0];
#pragma unroll
            for (int j = 0; j < 5; ++j)
#pragma unroll
                for (int s2 = 0; s2 < 2; ++s2) {
                    v4u pw; pw.x = cvt_pk_bf16(sc[j][8 * s2 + 0], sc[j][8 * s2 + 1]); pw.y = cvt_pk_bf16(sc[j][8 * s2 + 2], sc[j][8 * s2 + 3]); pw.z = cvt_pk_bf16(sc[j][8 * s2 + 4], sc[j][8 * s2 + 5]); pw.w = cvt_pk_bf16(sc[j][8 * s2 + 6], sc[j][8 * s2 + 7]);
                    const bf16x8 pf = __builtin_bit_cast(bf16x8, pw);
                    const LAS unsigned char* vp = lds + SW_VOFF + (32 * (a + j) + 16 * s2 + 4 * hh + tq) * SW_PITCH + (tcb + 4 * tp) * 2;
#pragma unroll
                    for (int dt = 0; dt < 2; ++dt) { const bf16x8 vf = mk8(lds_tr(vp + dt * 64), lds_tr(vp + dt * 64 + 8 * SW_PITCH));
                        oa[dt] = __builtin_amdgcn_mfma_f32_32x32x16_bf16(vf, pf, oa[dt], 0, 0, 0); }
                }
            bf16* yp = Y + rowq * DM + hq * 64 + 4 * hh;
#pragma unroll
            for (int dt = 0; dt < 2; ++dt)
#pragma unroll
                for (int gq = 0; gq < 4; ++gq) { v2u w; w.x = cvt_pk_bf16(oa[dt][4 * gq] * rinv, oa[dt][4 * gq + 1] * rinv); w.y = cvt_pk_bf16(oa[dt][4 * gq + 2] * rinv, oa[dt][4 * gq + 3] * rinv);
                    *(GAS v2u*)(yp + 32 * dt + 8 * gq) = w; }
        }
        __syncthreads();
    }
}


constexpr int G2_QD = 0, G2_KI = 34816, G2_KE = 69632, G2_QB = 17408, G2_QP = 272;
constexpr int G2_V = 104448, G2_VB = 5120, G2_VP = 80;
constexpr int G2_ST0 = 114688, G2_ST1 = RSTAB_OFF, G2_SP = 272;
constexpr int G2_BL = 123392;
static_assert(G2_ST0 + 32 * G2_SP <= G2_BL && G2_BL + 1024 <= RING_BYTES && G2_ST1 + 32 * G2_SP <= LDS_BYTES, "GLA LDS map");
#define GLA_BAR() asm volatile("s_waitcnt lgkmcnt(0)\n\ts_barrier" ::: "memory")
struct GlaIn { f32x4 b[2][4]; v4u q[2][2], k[2][2], v; };
__device__ __forceinline__ void gla_load(GlaIn& I, const bf16* Z, const float* LA, size_t R0, int h, int es, int pt) {
    const int prow = pt >> 3, pdc = pt & 7;
#pragma unroll
    for (int r = 0; r < 2; ++r) {
        const float* bp = LA + (R0 + prow + 32 * r) * 512 + h * 128 + 8 * pdc; const bf16* zr = Z + (R0 + prow + 32 * r) * NZ + h * 128 + 8 * pdc;
#pragma unroll
        for (int i = 0; i < 2; ++i) { I.b[r][2 * i] = *(const GAS f32x4*)(bp + 64 * i); I.b[r][2 * i + 1] = *(const GAS f32x4*)(bp + 64 * i + 4); I.q[r][i] = *(const GAS v4u*)(zr + ZQB + 64 * i); I.k[r][i] = *(const GAS v4u*)(zr + ZKB + 64 * i); }
    }
    I.v = *(const GAS v4u*)(Z + (R0 + (pt >> 2)) * NZ + ZVB + h * 256 + es * 32 + (pt & 3) * 8);
}
__device__ __forceinline__ void gla_pin(GlaIn& I) {
#pragma unroll
    for (int r = 0; r < 2; ++r) {
#pragma unroll
        for (int k = 0; k < 4; ++k) asm volatile("" : "+v"(I.b[r][k]));
#pragma unroll
        for (int i = 0; i < 2; ++i) { asm volatile("" : "+v"(I.q[r][i])); asm volatile("" : "+v"(I.k[r][i])); }
    }
    asm volatile("" : "+v"(I.v));
}
__device__ __forceinline__ void gla_prep(const GlaIn& I, LAS unsigned char* lds, int buf, int pt) {
    const int prow = pt >> 3, pdc = pt & 7;
#pragma unroll
    for (int r = 0; r < 2; ++r)
#pragma unroll
        for (int i = 0; i < 2; ++i) {
            float qf[8], kf[8]; un8(I.q[r][i], qf); un8(I.k[r][i], kf);
            float x[8], y[8];
#pragma unroll
            for (int j = 0; j < 8; ++j) { const float bb = I.b[r][2 * i + (j >> 2)][j & 3];
                const float e1 = __builtin_amdgcn_exp2f(bb), e2 = __builtin_amdgcn_rcpf(e1);
                x[j] = qf[j] * e1; y[j] = kf[j] * e2; }
            LAS unsigned char* wp = lds + buf * G2_QB + (prow + 32 * r) * G2_QP + (8 * pdc + 64 * i) * 2;
            v4u w;
            w.x = cvt_pk_bf16(x[0], x[1]); w.y = cvt_pk_bf16(x[2], x[3]); w.z = cvt_pk_bf16(x[4], x[5]); w.w = cvt_pk_bf16(x[6], x[7]); *(LAS v4u*)(wp + G2_QD) = w;
            w.x = cvt_pk_bf16(y[0], y[1]); w.y = cvt_pk_bf16(y[2], y[3]); w.z = cvt_pk_bf16(y[4], y[5]); w.w = cvt_pk_bf16(y[6], y[7]); *(LAS v4u*)(wp + G2_KI) = w;
        }
    if (prow == 31) {
#pragma unroll
        for (int i = 0; i < 2; ++i) { *(LAS f32x4*)(lds + G2_BL + buf * 512 + (8 * pdc + 64 * i) * 4) = I.b[1][2 * i]; *(LAS f32x4*)(lds + G2_BL + buf * 512 + (8 * pdc + 64 * i + 4) * 4) = I.b[1][2 * i + 1]; }
    }
    *(LAS v4u*)(lds + G2_V + buf * G2_VB + (pt >> 2) * G2_VP + (pt & 3) * 16) = I.v;
}
__device__ __forceinline__ void glds16_asm(const void* gsrc, unsigned lds_dst) {
    unsigned keep;
    asm volatile("s_mov_b32 %0, m0\n\ts_mov_b32 m0, %2\n\ts_nop 0\n\tglobal_load_lds_dwordx4 %1, off\n\ts_mov_b32 m0, %0" : "=&s"(keep) : "v"(gsrc), "s"(lds_dst) : "memory");
}
__device__ __forceinline__ void side_dma(const TItem& t, int lane, LAS float* scr, LAS float* gscr, const float* ones) {
    const float* p = t.src + (size_t)(lane >> 3) * t.ldw + 4 * (lane & 7);
    const unsigned dst = __builtin_amdgcn_readfirstlane((unsigned)(unsigned long long)scr), gdst = __builtin_amdgcn_readfirstlane((unsigned)(unsigned long long)gscr);
#pragma unroll
    for (int i = 0; i < 8; ++i) glds16_asm(p + (size_t)(8 * i) * t.ldw, dst + i * 1024);
    glds16_asm((t.gk ? t.gk : ones) + 4 * (lane & 15), gdst);
}
__device__ __forceinline__ void side_store(const TItem& t, int lane, LAS float* scr, const LAS float* gscr) {
    const int c = lane & 7;
    const f32x4 g0 = *(const LAS f32x4*)(gscr + 8 * c), g1 = *(const LAS f32x4*)(gscr + 8 * c + 4);
#pragma unroll
    for (int j = 0; j < 4; ++j) { const int n = (lane >> 3) + 8 * j; const LAS float* q = scr + (8 * c) * 32 + n;
        v4u o; o.x = cvt_pk_bf16(q[0 * 32] * g0[0], q[1 * 32] * g0[1]); o.y = cvt_pk_bf16(q[2 * 32] * g0[2], q[3 * 32] * g0[3]); o.z = cvt_pk_bf16(q[4 * 32] * g1[0], q[5 * 32] * g1[1]); o.w = cvt_pk_bf16(q[6 * 32] * g1[2], q[7 * 32] * g1[3]);
        *(GAS v4u*)(t.dst + (size_t)n * t.ldt + 8 * c) = o; }
    LDS_WAIT(); asm volatile("" ::: "memory");
}
constexpr int SIDE_GS = 141312;
static_assert(G2_ST1 + 32 * G2_SP <= SIDE_GS && SIDE_GS + 4096 <= LDS_BYTES, "GLA LDS map");
constexpr int SIDE_SCR = G2_KE;
static_assert(SIDE_SCR + 4 * 8192 <= G2_V, "GLA LDS map");
__device__ __forceinline__ void gla_phase(const bf16* Z, const float* LA, float* OS, LAS unsigned char* lds, int tid, int G, const SideJob& J, unsigned char* ws) {
    const int lane = tid & 63, wave = __builtin_amdgcn_readfirstlane(tid >> 6), r32 = lane & 31, hh = lane >> 5;
    const int tq = (lane & 15) >> 2, tp = lane & 3, tcb = 16 * ((lane >> 4) & 1);
    const f32x16 zero16 = {0.f, 0.f, 0.f, 0.f, 0.f, 0.f, 0.f, 0.f, 0.f, 0.f, 0.f, 0.f, 0.f, 0.f, 0.f, 0.f};
    const int nmain = J.l == 0 ? NS_ITEMS + I_IN : NS_ITEMS;
    bool side_first = true;
    for (int it = blockIdx.x; it < 256; it += G) {
        const int b = it & 7, h = (it >> 3) & 3, es = it >> 5;
        const size_t R00 = (size_t)b * SEQ;
        for (int i = tid; i < 32 * G2_SP / 16; i += NWAVES * 64) *(LAS v4u*)(lds + G2_ST0 + i * 16) = (v4u){0u, 0u, 0u, 0u};
        if (wave >= 4) {
            const int pt = tid - 256;
            GlaIn IA, IB;
            __builtin_amdgcn_s_waitcnt(0x0F70);
            gla_load(IA, Z, LA, R00, h, es, pt);
            gla_prep(IA, lds, 0, pt);
            gla_load(IA, Z, LA, R00 + 64, h, es, pt);
            asm volatile("" ::: "memory");
            gla_load(IB, Z, LA, R00 + 128, h, es, pt);
            GLA_BAR();
            for (int t = 0; t < 32; t += 2) {
                gla_pin(IA); gla_prep(IA, lds, 1, pt);
                gla_load(IA, Z, LA, R00 + 64 * (t + 3 < 32 ? t + 3 : 31), h, es, pt);
                GLA_BAR();
                gla_pin(IB); gla_prep(IB, lds, 0, pt);
                gla_load(IB, Z, LA, R00 + 64 * (t + 4 < 32 ? t + 4 : 31), h, es, pt);
                GLA_BAR();
            }
        } else {
            f32x16 S0 = zero16, S1 = zero16;
            const bool side_on = side_first && wave >= 2;
            LAS float* sscr = (LAS float*)(lds + SIDE_SCR + (wave >= 2 ? wave - 2 : 0) * 16384);
            LAS float* sgs = (LAS float*)(lds + SIDE_GS + (wave >= 2 ? wave - 2 : 0) * 2048);
            const float* ones = (const float*)(ws + WS_ONES);
            if (side_on) {
#pragma unroll
                for (int j = 0; j < 2; ++j) { const int gi = (2 * j + (wave - 2)) * G + (int)blockIdx.x; if (gi < nmain) { const TItem d = decode_job(J, ws, gi); side_dma(d, lane, sscr + j * 2048, sgs + j * 256, ones); } }
            }
            GLA_BAR();
            for (int t = 0; t < 32; ++t) {
                const int buf = t & 1;
                if (wave < 2) {
                    const int lt = wave;
                    const LAS unsigned char* qdp = lds + G2_QD + buf * G2_QB + (32 * lt + r32) * G2_QP + 16 * hh;
                    const LAS unsigned char* stp = lds + (buf ? G2_ST1 : G2_ST0) + r32 * G2_SP + 16 * hh;
                    const LAS unsigned char* kip = lds + G2_KI + buf * G2_QB + r32 * G2_QP + 16 * hh;
                    bf16x8 qf[8], fr[8];
#pragma unroll
                    for (int ks = 0; ks < 8; ++ks) { qf[ks] = *(const LAS bf16x8*)(qdp + 32 * ks); fr[ks] = *(const LAS bf16x8*)(kip + 32 * ks); }
                    f32x16 a = zero16, o = zero16;
#pragma unroll
                    for (int ks = 0; ks < 8; ++ks) a = __builtin_amdgcn_mfma_f32_32x32x16_bf16(fr[ks], qf[ks], a, 0, 0, 0);
#pragma unroll
                    for (int ks = 0; ks < 8; ++ks) fr[ks] = *(const LAS bf16x8*)(stp + 32 * ks);
#pragma unroll
                    for (int ks = 0; ks < 8; ++ks) o = __builtin_amdgcn_mfma_f32_32x32x16_bf16(fr[ks], qf[ks], o, 0, 0, 0);
                    if (lt == 1) {
#pragma unroll
                        for (int ks = 0; ks < 8; ++ks) fr[ks] = *(const LAS bf16x8*)(kip + 32 * G2_QP + 32 * ks);
                    }
                    const LAS unsigned char* vp = lds + G2_V + buf * G2_VB + (4 * hh + tq) * G2_VP + (tcb + 4 * tp) * 2;
                    if (lt == 0) {
#pragma unroll
                        for (int rho = 0; rho < 16; ++rho) { const int sr = (rho & 3) + 8 * (rho >> 2) + 4 * hh; a[rho] = r32 >= sr ? a[rho] : 0.f; }
                    }
#pragma unroll
                    for (int s2 = 0; s2 < 2; ++s2) {
                        v4u pw; pw.x = cvt_pk_bf16(a[8 * s2 + 0], a[8 * s2 + 1]); pw.y = cvt_pk_bf16(a[8 * s2 + 2], a[8 * s2 + 3]); pw.z = cvt_pk_bf16(a[8 * s2 + 4], a[8 * s2 + 5]); pw.w = cvt_pk_bf16(a[8 * s2 + 6], a[8 * s2 + 7]);
                        const bf16x8 vf = mk8(lds_tr(vp + 16 * s2 * G2_VP), lds_tr(vp + (16 * s2 + 8) * G2_VP));
                        o = __builtin_amdgcn_mfma_f32_32x32x16_bf16(vf, __builtin_bit_cast(bf16x8, pw), o, 0, 0, 0);
                    }
                    if (lt == 1) {
                        a = zero16;
#pragma unroll
                        for (int ks = 0; ks < 8; ++ks) a = __builtin_amdgcn_mfma_f32_32x32x16_bf16(fr[ks], qf[ks], a, 0, 0, 0);
#pragma unroll
                        for (int rho = 0; rho < 16; ++rho) { const int sr = (rho & 3) + 8 * (rho >> 2) + 4 * hh; a[rho] = r32 >= sr ? a[rho] : 0.f; }
#pragma unroll
                        for (int s2 = 0; s2 < 2; ++s2) {
                            v4u pw; pw.x = cvt_pk_bf16(a[8 * s2 + 0], a[8 * s2 + 1]); pw.y = cvt_pk_bf16(a[8 * s2 + 2], a[8 * s2 + 3]); pw.z = cvt_pk_bf16(a[8 * s2 + 4], a[8 * s2 + 5]); pw.w = cvt_pk_bf16(a[8 * s2 + 6], a[8 * s2 + 7]);
                            const bf16x8 vf = mk8(lds_tr(vp + (32 + 16 * s2) * G2_VP), lds_tr(vp + (32 + 16 * s2 + 8) * G2_VP));
                            o = __builtin_amdgcn_mfma_f32_32x32x16_bf16(vf, __builtin_bit_cast(bf16x8, pw), o, 0, 0, 0);
                        }
                    }
                    bf16* op = (bf16*)OS + (R00 + 64 * t + 32 * wave + r32) * 1024 + h * 256 + es * 32 + 4 * hh;
#pragma unroll
                    for (int g = 0; g < 4; ++g) { v2u w; w.x = cvt_pk_bf16(o[4 * g], o[4 * g + 1]); w.y = cvt_pk_bf16(o[4 * g + 2], o[4 * g + 3]); *(GAS v2u*)(op + 8 * g) = w; }
                } else {
                    LAS unsigned char* stn = lds + (buf ? G2_ST0 : G2_ST1);
                    const LAS unsigned char* vp = lds + G2_V + buf * G2_VB + (8 * hh + tq) * G2_VP + (tcb + 4 * tp) * 2;
                    const LAS unsigned char* kp = lds + G2_KI + buf * G2_QB + (8 * hh + tq) * G2_QP + (64 * (wave - 2) + tcb + 4 * tp) * 2;
                    bf16x8 vf8[4], k0[4], k1[4];
#pragma unroll
                    for (int ks = 0; ks < 4; ++ks) { vf8[ks] = mk8(lds_tr(vp + 16 * ks * G2_VP), lds_tr(vp + (16 * ks + 4) * G2_VP));
                        k0[ks] = mk8(lds_tr(kp + 16 * ks * G2_QP), lds_tr(kp + (16 * ks + 4) * G2_QP)); k1[ks] = mk8(lds_tr(kp + 64 + 16 * ks * G2_QP), lds_tr(kp + 64 + (16 * ks + 4) * G2_QP)); }
#pragma unroll
                    for (int ks = 0; ks < 4; ++ks) { S0 = __builtin_amdgcn_mfma_f32_32x32x16_bf16(k0[ks], vf8[ks], S0, 0, 0, 0); S1 = __builtin_amdgcn_mfma_f32_32x32x16_bf16(k1[ks], vf8[ks], S1, 0, 0, 0); }
#pragma unroll
                    for (int rho = 0; rho < 16; ++rho) { const LAS float* bp = (const LAS float*)(lds + G2_BL + buf * 512) + 64 * (wave - 2) + (rho & 3) + 8 * (rho >> 2) + 4 * hh; S0[rho] *= __builtin_amdgcn_exp2f(bp[0]); S1[rho] *= __builtin_amdgcn_exp2f(bp[32]); }
#pragma unroll
                    for (int g = 0; g < 4; ++g) {
                        v2u w; w.x = cvt_pk_bf16(S0[4 * g], S0[4 * g + 1]); w.y = cvt_pk_bf16(S0[4 * g + 2], S0[4 * g + 3]); *(LAS v2u*)(stn + r32 * G2_SP + (64 * (wave - 2) + 8 * g + 4 * hh) * 2) = w;
                        w.x = cvt_pk_bf16(S1[4 * g], S1[4 * g + 1]); w.y = cvt_pk_bf16(S1[4 * g + 2], S1[4 * g + 3]); *(LAS v2u*)(stn + r32 * G2_SP + (64 * (wave - 2) + 32 + 8 * g + 4 * hh) * 2) = w;
                    }
                    if (side_on) {
                        { const int gnx = (2 * (t + 1) + (wave - 2)) * G + (int)blockIdx.x;
                          if (t + 1 < 32 && gnx < nmain) { if (t == 0) asm volatile("s_waitcnt vmcnt(9)" ::: "memory"); else asm volatile("s_waitcnt vmcnt(13)" ::: "memory"); } else asm volatile("s_waitcnt vmcnt(0)" ::: "memory"); }
                        LAS float* sb = sscr + buf * 2048; LAS float* gb = sgs + buf * 256;
                        int ls = lane; asm volatile("" : "+v"(ls));
                        const int gi = (2 * t + (wave - 2)) * G + (int)blockIdx.x;
                        if (gi < nmain) { const TItem d = decode_job(J, ws, gi); side_store(d, ls, sb, gb); }
                        const int gn = (2 * (t + 2) + (wave - 2)) * G + (int)blockIdx.x;
                        if (t + 2 < 32 && gn < nmain) { const TItem d = decode_job(J, ws, gn); side_dma(d, ls, sb, gb, ones); }
                    }
                }
                GLA_BAR();
            }
        }
        __syncthreads();
        side_first = false;
    }
    {
        float sv[32]; f32x4 sg[2];
        LAS float* scr = (LAS float*)(lds + RING_OFF + wave * 16384);
        for (int q = 64 + wave; ; q += NWAVES) { const int gi = q * G + (int)blockIdx.x; if (gi >= nmain) break; const TItem d = decode_job(J, ws, gi); titem_load(d, lane, sv, sg); titem_store(d, lane, sv, sg, scr); }
        if (J.l == 0) for (int r = (int)blockIdx.x * NWAVES + wave; r < I_AL; r += G * NWAVES) { const int kb = r / 16, jb = r % 16; alpha_item((const float*)J.ap->in[3] + (size_t)DM * WIN_LD, (const float*)J.ap->in[5] + 16 * 512, (const float*)J.ap->in[2] + DM, kb * 64, jb * 32, (bf16*)(ws + WS_WIN), scr, lane); }
    }
}
__device__ __forceinline__ void yb_norm(const float* OS, const bf16* Z, const float* gg, bf16* Y, int gw, int NGW, int lane) {
    const f32x4 g = *(const GAS f32x4*)(gg + 4 * lane);
    for (int item0 = gw * 4; item0 < M * 4; item0 += NGW * 4) {
        f32x4 o[4]; v2u r[4]; float ss[4];
#pragma unroll
        for (int k = 0; k < 4; ++k) { const int item = item0 + k, row = item >> 2, h = item & 3;
            { const v2u ow = *(const GAS v2u*)((const bf16*)OS + (size_t)row * 1024 + h * 256 + 4 * lane); o[k] = (f32x4){bflo(ow.x), bfhi(ow.x), bflo(ow.y), bfhi(ow.y)}; } r[k] = *(const GAS v2u*)(Z + (size_t)row * NZ + ZRB + h * 256 + 4 * lane);
            ss[k] = (o[k].x * o[k].x + o[k].y * o[k].y) + (o[k].z * o[k].z + o[k].w * o[k].w); }
#pragma unroll
        for (int off = 1; off < 64; off <<= 1) {
#pragma unroll
            for (int k = 0; k < 4; ++k) ss[k] += __shfl_xor(ss[k], off); }
#pragma unroll
        for (int k = 0; k < 4; ++k) { const int item = item0 + k, row = item >> 2, h = item & 3;
            const float rs = 1.0f / sqrtf(ss[k] * (1.0f / 256.0f) + pg8::RMS_EPS);
            v2u w; w.x = cvt_pk_bf16(o[k].x * rs * g.x * bflo(r[k].x), o[k].y * rs * g.y * bfhi(r[k].x)); w.y = cvt_pk_bf16(o[k].z * rs * g.z * bflo(r[k].y), o[k].w * rs * g.w * bfhi(r[k].y));
            *(GAS v2u*)(Y + (size_t)row * DM + 1024 + h * 256 + 4 * lane) = w; }
    }
}
__device__ __forceinline__ void conv_fixup(const bf16* HF, const bf16* HL, const float* cw, const float* cb, bf16* ACT, int pm, int tid) {
    for (int cg = tid; cg < 704; cg += NWAVES * 64) {
        const int c0 = cg * 8, pn = c0 >> 7, j0 = c0 & 127, hcol = 256 * pn + j0;
        const bool first = (pm & 7) == 0;
        float h[4][2][8];
#pragma unroll
        for (int k = 0; k < 2; ++k)
#pragma unroll
            for (int gu = 0; gu < 2; ++gu) {
                v4u a = {0u, 0u, 0u, 0u};
                if (!first) a = *(const GAS v4u*)(HL + (size_t)((pm - 1) * 2 + k) * NH + hcol + 128 * gu);
                const v4u b = *(const GAS v4u*)(HF + (size_t)(pm * 2 + k) * NH + hcol + 128 * gu);
                un8h(a, h[k][gu]); un8h(b, h[2 + k][gu]);
            }
#pragma unroll
        for (int k = 0; k < 2; ++k) {
            float a[8];
#pragma unroll
            for (int i = 0; i < 8; ++i) {
                const int c = c0 + i;
                const float gc = cb[c] + cw[c] * h[k][0][i] + cw[NH + c] * h[k + 1][0][i] + cw[2 * NH + c] * h[k + 2][0][i];
                const float uc = cb[DFF + c] + cw[DFF + c] * h[k][1][i] + cw[NH + DFF + c] * h[k + 1][1][i] + cw[2 * NH + DFF + c] * h[k + 2][1][i];
                a[i] = gc * pg8::sigmoidf_fast(gc) * uc;
            }
            v4u w; w.x = cvt_pk_bf16(a[0], a[1]); w.y = cvt_pk_bf16(a[2], a[3]); w.z = cvt_pk_bf16(a[4], a[5]); w.w = cvt_pk_bf16(a[6], a[7]);
            *(GAS v4u*)(ACT + (size_t)(pm * 256 + k) * DFF + c0) = w;
        }
    }
}
__device__ __forceinline__ void final_norm(const bf16* xb, float* out, const float* fg, int gw, int NGW, int lane) {
    for (int m0 = gw * 2; m0 < M; m0 += NGW * 2) {
        v4u v[2][4]; float s[2] = {0.f, 0.f};
#pragma unroll
        for (int k = 0; k < 2; ++k) { const GAS v4u* xr = (const GAS v4u*)(xb + (size_t)(m0 + k) * DM) + lane;
#pragma unroll
            for (int j = 0; j < 4; ++j) { v[k][j] = xr[64 * j]; float f[8]; un8(v[k][j], f);
#pragma unroll
                for (int i = 0; i < 8; ++i) s[k] += f[i] * f[i]; } }
#pragma unroll
        for (int off = 1; off < 64; off <<= 1) { s[0] += __shfl_xor(s[0], off); s[1] += __shfl_xor(s[1], off); }
#pragma unroll
        for (int k = 0; k < 2; ++k) { const float rs = 1.0f / sqrtf(s[k] * (1.0f / DM) + pg8::RMS_EPS);
#pragma unroll
            for (int j = 0; j < 4; ++j) { float f[8]; un8(v[k][j], f); const GAS f32x4* gr = (const GAS f32x4*)(fg + 8 * lane + 512 * j); GAS f32x4* orow = (GAS f32x4*)(out + (size_t)(m0 + k) * DM + 8 * lane + 512 * j);
                const f32x4 g0 = gr[0], g1 = gr[1];
                orow[0] = (f32x4){f[0] * rs * g0[0], f[1] * rs * g0[1], f[2] * rs * g0[2], f[3] * rs * g0[3]}; orow[1] = (f32x4){f[4] * rs * g1[0], f[5] * rs * g1[1], f[6] * rs * g1[2], f[7] * rs * g1[3]}; } }
    }
}
__global__ void __launch_bounds__(NWAVES * 64, 2) fwd(Args args) {
    extern __shared__ __attribute__((aligned(16))) unsigned char lds_raw[];
    LAS unsigned char* lds = (LAS unsigned char*)lds_raw;
    volatile LAS unsigned* MISC = (volatile LAS unsigned*)(lds + MISC_OFF);
    const int wave_s = __builtin_amdgcn_readfirstlane((int)threadIdx.x >> 6);
    const int G = gridDim.x, NGW = G * NWAVES, NT = G * NWAVES * 64;
    {
        const int tid = threadIdx.x;
        for (int u = tid; u < (LDS_BYTES - LDSCTL_OFF) / 4 && u < 256; u += NWAVES * 64) ((LAS unsigned*)(lds + LDSCTL_OFF))[u] = 0u;
    }
    __syncthreads();
    XcdBarrier bar = xcd_barrier_post((unsigned*)((gu32*)(args.ws + WS_CTL) + CW_BAR), MISC + 8);
    const int lo = args.ph_lo, hi = args.ph_hi;
#define IN(p) (lo <= (p) && (p) < hi)
#define SEAM(p) do { if (IN(p) && IN((p) + 1)) { XcdBarrier b2 = bar; asm volatile("" : "+s"(b2.x)); xcd_barrier(b2); } } while (0)

    for (int l = 0; l < 2; ++l) {
        const int pb = 9 * l;
#define INP(k) ((const float*)ap->in[k])
#define PHASE_IDS() const __attribute__((address_space(4))) Args* ap = (const __attribute__((address_space(4))) Args*)__builtin_amdgcn_kernarg_segment_ptr(); asm volatile("" : "+s"(ap)); unsigned char* const ws = ap->ws; (void)ws; unsigned ones_ = ~0u; asm volatile("" : "+s"(ones_)); int tidp = wave_s * 64 + (int)__builtin_amdgcn_mbcnt_hi(ones_, __builtin_amdgcn_mbcnt_lo(ones_, 0u)); asm volatile("" : "+v"(tidp)); const int lanep = tidp & 63, wavep = __builtin_amdgcn_readfirstlane(tidp >> 6), gwp = blockIdx.x * NWAVES + wavep, gtp = blockIdx.x * (NWAVES * 64) + tidp; (void)lanep; (void)gwp; (void)gtp
        if (IN(pb + 0) && l == 0) { PHASE_IDS();
            LayerIn L;
            L.gmix = INP(2); L.win = INP(3); L.wau = INP(5);
            phase_weights(L, ws, lds, gwp, NGW, wavep, lanep);
            phase_xprep(INP(0), (const int*)ap->in[1], ws, gwp, NGW, lanep);
        }
        if (l == 0) SEAM(pb + 0);
        if (IN(pb + 1)) { PHASE_IDS();
            pg8::Gemm g{(bf16*)(ws + WS_XB), (bf16*)(ws + WS_WIN), M, NZ, DM, DM, nullptr, nullptr}; pg8::StaticOrder S; S.init(M, NZ, G, (int)blockIdx.x);
            fill_rstd_table((float*)(ws + WS_SSQ), lds, tidp);
            pg8::EpiZ E{(bf16*)(ws + WS_ZB), (float*)(ws + WS_LA), (const LAS float*)(lds + RSTAB_OFF), (float*)(ws + WS_ROPE), INP(6) + l * 512};
            pg8::gemm_phase<pg8::EpiZ, pg8::StaticOrder, true, true>(lds + RING_OFF, g, S, E, tidp);
        }
        SEAM(pb + 1);
        if (IN(pb + 2)) { PHASE_IDS(); swa_phase((bf16*)(ws + WS_ZB), INP(4) + l * 16, (bf16*)(ws + WS_Y), lds, tidp, G); int tid2 = tidp; asm volatile("" : "+v"(tid2)); SideJob J; J.ap = ap; J.l = l; gla_phase((bf16*)(ws + WS_ZB), (float*)(ws + WS_LA), ap->out, lds, tid2, G, J, ws); }
        SEAM(pb + 2);
        if (IN(pb + 3)) { PHASE_IDS(); yb_norm(ap->out, (bf16*)(ws + WS_ZB), INP(7) + l * 256, (bf16*)(ws + WS_Y), gwp, NGW, lanep); }
        SEAM(pb + 3);
        if (IN(pb + 4)) { PHASE_IDS();
            pg8::Gemm g{(bf16*)(ws + WS_Y), (bf16*)(ws + WS_WA), M, DM, 1024, DM, (bf16*)(ws + WS_Y) + 1024, (bf16*)(ws + WS_WB)}; pg8::TwoSegOrder S; S.init(M, DM, G, (int)blockIdx.x);
            pg8::EpiMix E{(bf16*)(ws + WS_MIX), (bf16*)(ws + WS_ZB) + ZGA, (bf16*)(ws + WS_ZB) + ZGB};
            pg8::gemm_phase<pg8::EpiMix, pg8::TwoSegOrder, true, true>(lds + RING_OFF, g, S, E, tidp);
        }
        SEAM(pb + 4);
        if (IN(pb + 5)) { PHASE_IDS();
            pg8::Gemm g{(bf16*)(ws + WS_MIX), (bf16*)(ws + WS_WO), M, DM, DM, DM, nullptr, nullptr}; pg8::StaticOrder S; S.init(M, DM, G, (int)blockIdx.x);
            pg8::EpiRes E{(bf16*)(ws + WS_XB), (float*)(ws + WS_SSQ)};
            pg8::gemm_phase<pg8::EpiRes, pg8::StaticOrder, true, true>(lds + RING_OFF, g, S, E, tidp);
        }
        SEAM(pb + 5);
        if (IN(pb + 6)) { PHASE_IDS();
            pg8::Gemm g{(bf16*)(ws + WS_XB), (bf16*)(ws + WS_WUP), M, NH, DM, DM, nullptr, nullptr}; pg8::StaticOrder S; S.init(M, NH, G, (int)blockIdx.x);
            fill_rstd_table((float*)(ws + WS_SSQ), lds, tidp);
            pg8::EpiUp E{(bf16*)(ws + WS_ACT), (const LAS float*)(lds + RSTAB_OFF), (LAS unsigned*)(lds + XL_OFF), (LAS unsigned*)(lds + CWL_OFF), INP(13) + (size_t)l * 3 * NH, INP(14) + (size_t)l * NH, (bf16*)(ws + WS_HF), (bf16*)(ws + WS_HL)};
            pg8::gemm_phase<pg8::EpiUp, pg8::StaticOrder, true, true>(lds + RING_OFF, g, S, E, tidp);
        }
        SEAM(pb + 6);
        if (IN(pb + 8)) { PHASE_IDS();
            pg8::Gemm g{(bf16*)(ws + WS_ACT), (bf16*)(ws + WS_WDN), M, DM, DFF, DFF, nullptr, nullptr}; pg8::StaticOrder S; S.init(M, DM, G, (int)blockIdx.x);
            {
                pg8::Unit uu; int prev = -1;
                for (int i = 0; S.next(i, uu); ++i) if (uu.pm != prev) { prev = uu.pm; conv_fixup((bf16*)(ws + WS_HF), (bf16*)(ws + WS_HL), INP(13) + (size_t)l * 3 * NH, INP(14) + (size_t)l * NH, (bf16*)(ws + WS_ACT), uu.pm, tidp); }
                asm volatile("s_waitcnt vmcnt(0)" ::: "memory"); __syncthreads();
            }
            pg8::EpiRes E{(bf16*)(ws + WS_XB), (float*)(ws + WS_SSQ)};
            pg8::gemm_phase<pg8::EpiRes, pg8::StaticOrder, true, true>(lds + RING_OFF, g, S, E, tidp);
        }
        SEAM(pb + 8);
    }
    if (IN(18)) { PHASE_IDS(); final_norm((const bf16*)(ws + WS_XB), ap->out, (const float*)ap->in[16], gwp, NGW, lanep); }
#undef IN
#undef SEAM
}

#ifndef N_LAUNCH_MODE
#define N_LAUNCH_MODE 1
#endif
extern "C" void kernel_launch(void* const* d_in, const int* in_sizes, int n_in, void* d_out, int out_size, void* d_ws, size_t ws_size, hipStream_t stream) {
    static int grid = 0;
    if (grid == 0) {
        if (n_in != 17 || out_size != M * DM || ws_size < WS_END) { fprintf(stderr, "kernel_launch: unexpected shapes (n_in %d out %d ws %zu)\n", n_in, out_size, ws_size); grid = -1; return; }
        int dev = 0, cus = 0, per_cu = 0;
        if (hipGetDevice(&dev) != hipSuccess || hipDeviceGetAttribute(&cus, hipDeviceAttributeMultiprocessorCount, dev) != hipSuccess) { grid = -1; return; }
        if (hipFuncSetAttribute((const void*)fwd, hipFuncAttributeMaxDynamicSharedMemorySize, LDS_BYTES) != hipSuccess) { fprintf(stderr, "kernel_launch: hipFuncSetAttribute failed\n"); grid = -1; return; }
        if (hipOccupancyMaxActiveBlocksPerMultiprocessor(&per_cu, (const void*)fwd, NWAVES * 64, LDS_BYTES) != hipSuccess || per_cu < 1) fprintf(stderr, "kernel_launch: occupancy query reports %d\n", per_cu);
        (void)hipGetLastError();
        grid = cus;
        if (grid % 8 != 0) { fprintf(stderr, "kernel_launch: CU count %d is not a multiple of 8 (the per-CU row-statistics table assumes it)\n", grid); grid = -1; return; }
    }
    if (grid < 0) return;
    if (hipMemsetAsync((char*)d_ws + WS_CTL, 0, CTL_ZERO_BYTES, stream) != hipSuccess) return;
    Args a{};
    for (int i = 0; i < 17; ++i) a.in[i] = d_in[i];
    a.out = (float*)d_out; a.ws = (unsigned char*)d_ws;
    if (N_LAUNCH_MODE == 1) { a.ph_lo = 0; a.ph_hi = N_PHASES; hipLaunchKernelGGL(fwd, dim3(grid), dim3(NWAVES * 64), LDS_BYTES, stream, a); }
    else for (int p = 0; p < N_PHASES; ++p) { a.ph_lo = p; a.ph_hi = p + 1; hipLaunchKernelGGL(fwd, dim3(grid), dim3(NWAVES * 64), LDS_BYTES, stream, a); }
}
```

```cpp
#include <hip/hip_runtime.h>
#include <cstdio>
#include <cstdint>
#include <cmath>
namespace pg8 {
#define PG8_LAS __attribute__((address_space(3)))
typedef unsigned short bf16_t;
typedef short bf16x8 __attribute__((ext_vector_type(8)));
typedef float f32x4 __attribute__((ext_vector_type(4)));
typedef unsigned u32x4 __attribute__((ext_vector_type(4)));
constexpr int BM = 256, BK = 64, HALF = 128, HTB = HALF * BK * 2  , STAGE_BYTES = 8 * HTB, NXCD = 8, WGM = 8;

__host__ __device__ __forceinline__ int lds_byte(int r, int c) { const int st = (r >> 4) * 2 + (c >> 5), rr = r & 15, cc = c & 31, ob = rr * 64 + cc * 2; return st * 1024 + (ob ^ (((ob >> 9) & 1) << 5)); }
__host__ __device__ __forceinline__ void stage_rc(int b, int& R, int& C) { const int st = b / 1024, sb = b % 1024, swz = sb ^ (((sb >> 9) & 1) << 5); R = (st >> 1) * 16 + swz / 64; C = (st & 1) * 32 + (swz % 64) / 2; }
__host__ __device__ __forceinline__ int perm32(int rho) { const int n = rho >> 4, i = rho & 15; return 8 * (i >> 2) + 4 * n + (i & 3); }

struct Unit { int pm, pn, seg; };
struct Gemm { const bf16_t* A; const bf16_t* Bt; int M, N, K, lda; const bf16_t* A1; const bf16_t* Bt1; };

struct StaticOrder {
    int nM, nN, nwg, G, c;
    __host__ __device__ void init(int M, int N, int G_, int c_) { nM = M / BM; nN = N / BM; nwg = nM * nN; G = G_; c = c_; }
    __host__ __device__ bool next(int i, Unit& u) const {
        const long L = (long)i * G + c; if (L >= nwg) return false;
        int wgid = (int)L; { const int q = nwg / NXCD, r = nwg % NXCD, xcd = wgid % NXCD, off = wgid / NXCD; wgid = (xcd < r ? xcd * (q + 1) : r * (q + 1) + (xcd - r) * q) + off; }
        const int nig = WGM * nN, gid = wgid / nig, fm = gid * WGM, gsz = (nM - fm) < WGM ? (nM - fm) : WGM;
        u.pm = fm + ((wgid % nig) % gsz); u.pn = (wgid % nig) / gsz; u.seg = 0; return true;
    }
    __device__ __forceinline__ void a_ready(const Unit&) const {}
    __device__ __forceinline__ void done(const Unit&) const {}
};

struct TwoSegOrder : StaticOrder {
    __host__ __device__ bool next(int i, Unit& u) const { if (!StaticOrder::next(i >> 1, u)) return false; u.seg = i & 1; return true; }
};
typedef float f32x2_t __attribute__((ext_vector_type(2))); typedef __bf16 bf16x2_t __attribute__((ext_vector_type(2)));
__device__ __forceinline__ unsigned cvt_pk_bf16(float lo, float hi) { const f32x2_t v = {lo, hi}; const bf16x2_t b = __builtin_convertvector(v, bf16x2_t); return __builtin_bit_cast(unsigned, b); }
__device__ __forceinline__ u32x4 pack8(f32x4 a, f32x4 b) { u32x4 w; w.x = cvt_pk_bf16(a[0], a[1]); w.y = cvt_pk_bf16(a[2], a[3]); w.z = cvt_pk_bf16(b[0], b[1]); w.w = cvt_pk_bf16(b[2], b[3]); return w; }
__device__ __forceinline__ f32x4 unlo(u32x4 w) { return (f32x4){__uint_as_float(w.x << 16), __uint_as_float(w.x & 0xffff0000u), __uint_as_float(w.y << 16), __uint_as_float(w.y & 0xffff0000u)}; }
__device__ __forceinline__ f32x4 unhi(u32x4 w) { return (f32x4){__uint_as_float(w.z << 16), __uint_as_float(w.z & 0xffff0000u), __uint_as_float(w.w << 16), __uint_as_float(w.w & 0xffff0000u)}; }

constexpr int NZ = 9216;
constexpr int ZQA = 0, ZKA = 1024, ZVA = 1280, ZQB = 1536, ZKB = 2048, ZVB = 2560, ZRB = 3584, ZAL = 4608, ZGA = 5120, ZGB = 7168;
constexpr float LOG2E = 1.4426950408889634f;
constexpr float QA_SCALE = 0.125f * LOG2E;
constexpr float QB_SCALE = 0.08838834764831845f;
constexpr float RMS_EPS = 1e-6f;

__device__ __forceinline__ float row_rstd(const float* ssq, int row, int fq) {
    const f32x4* p = (const f32x4*)(ssq + (size_t)row * 32 + fq * 8);
    const f32x4 a = p[0], b = p[1];
    float s = ((a[0] + a[1]) + (a[2] + a[3])) + ((b[0] + b[1]) + (b[2] + b[3]));
    s += __shfl_xor(s, 16); s += __shfl_xor(s, 32);
    return 1.0f / sqrtf(s * (1.0f / 2048.0f) + RMS_EPS);
}
__device__ __forceinline__ float sigmoidf_fast(float x) { return __builtin_amdgcn_rcpf(1.0f + __expf(-x)); }

template <int CTRL, bool ZFILL> __device__ __forceinline__ float dppf(float x) { return __builtin_bit_cast(float, __builtin_amdgcn_update_dpp(0, __builtin_bit_cast(int, x), CTRL, 0xf, 0xf, ZFILL)); }
struct EpiZ {
    static constexpr bool PERM = true, AFTER_DRAIN = false; static __device__ __forceinline__ bool keeps_acc(const Unit&) { return false; }
    bf16_t* Z; float* LA; const PG8_LAS float* rsl; const float* cs; const float* balpha;
    __device__ __forceinline__ void operator()(const f32x4 (&acc)[2][2][4][2], const Unit& u, int wr, int wc, int fr, int fq) const {
        const int pn = u.pn, row0 = u.pm * BM + wr * 64 + fr, colw = wc * 32 + 8 * fq;
        float rs[2][4];
#pragma unroll
        for (int ai = 0; ai < 2; ++ai)
#pragma unroll
            for (int m = 0; m < 4; ++m) rs[ai][m] = rsl[(row0 + ai * HALF + m * 16) & 2047];
        if (pn < 5) {
            const bool rot = (wc & 1) == 0;
            const float post = pn < 4 ? QA_SCALE : 1.0f;
            const float sgn = fq == 0 ? -1.0f : (fq == 1 ? 1.0f : 0.0f);
#pragma unroll
            for (int ai = 0; ai < 2; ++ai)
#pragma unroll
            for (int mb = 0; mb < 4; mb += 2) {
                f32x4 ct[2][4];
                if (rot) {
#pragma unroll
                    for (int mm = 0; mm < 2; ++mm) { const f32x4* cp = (const f32x4*)(cs + (size_t)(row0 + ai * HALF + (mb + mm) * 16) * 16);
#pragma unroll
                        for (int q = 0; q < 4; ++q) ct[mm][q] = cp[q]; }
                }
                asm volatile("" ::: "memory");
#pragma unroll
                for (int mm = 0; mm < 2; ++mm) {
                    const int m = mb + mm, row = row0 + ai * HALF + m * 16;
                    const float sc = rs[ai][m] * post;
                    f32x4 v[2][2];
#pragma unroll
                    for (int bj = 0; bj < 2; ++bj)
#pragma unroll
                        for (int n = 0; n < 2; ++n) v[bj][n] = acc[ai][bj][m][n] * sc;
                    if (rot) {
                        float cc[8], sn[8];
#pragma unroll
                        for (int j = 0; j < 8; ++j) { cc[j] = fq < 2 ? ct[mm][j >> 1][2 * (j & 1)] : 1.0f; sn[j] = ct[mm][j >> 1][2 * (j & 1) + 1] * sgn; }
#pragma unroll
                        for (int bj = 0; bj < 2; ++bj)
#pragma unroll
                            for (int n = 0; n < 2; ++n)
#pragma unroll
                                for (int i = 0; i < 4; ++i) { const float own = v[bj][n][i], oth = __shfl_xor(own, 16); v[bj][n][i] = own * cc[4 * n + i] + oth * sn[4 * n + i]; }
                    }
                    bf16_t* rowp = Z + (size_t)row * NZ + pn * BM + colw;
#pragma unroll
                    for (int bj = 0; bj < 2; ++bj) *(u32x4*)(rowp + bj * HALF) = pack8(v[bj][0], v[bj][1]);
                }
                asm volatile("" ::: "memory");
            }
        } else if (pn == 18 || pn == 19) {
            f32x4 bb[2][2];
#pragma unroll
            for (int bj = 0; bj < 2; ++bj)
#pragma unroll
                for (int n = 0; n < 2; ++n) bb[bj][n] = *(const f32x4*)(balpha + (pn - 18) * 256 + bj * HALF + colw + 4 * n);
            const int l15 = (fq * 16 + 15) * 4;
#pragma unroll
            for (int ai = 0; ai < 2; ++ai)
#pragma unroll
                for (int bj = 0; bj < 2; ++bj)
#pragma unroll
                    for (int n = 0; n < 2; ++n) {
                        f32x4 carry = {0.f, 0.f, 0.f, 0.f};
#pragma unroll
                        for (int m = 0; m < 4; ++m) {
                            float s0, s1, s2, s3;
                            {
                                const f32x4 x = acc[ai][bj][m][n] * rs[ai][m] + bb[bj][n];
                                s0 = fminf(x[0], 0.0f) * (LOG2E / 16.0f) - __builtin_amdgcn_logf(1.0f + __builtin_amdgcn_exp2f(-fabsf(x[0]) * LOG2E)) * (1.0f / 16.0f);
                                s1 = fminf(x[1], 0.0f) * (LOG2E / 16.0f) - __builtin_amdgcn_logf(1.0f + __builtin_amdgcn_exp2f(-fabsf(x[1]) * LOG2E)) * (1.0f / 16.0f);
                                s2 = fminf(x[2], 0.0f) * (LOG2E / 16.0f) - __builtin_amdgcn_logf(1.0f + __builtin_amdgcn_exp2f(-fabsf(x[2]) * LOG2E)) * (1.0f / 16.0f);
                                s3 = fminf(x[3], 0.0f) * (LOG2E / 16.0f) - __builtin_amdgcn_logf(1.0f + __builtin_amdgcn_exp2f(-fabsf(x[3]) * LOG2E)) * (1.0f / 16.0f);
                            }
                            asm volatile("s_nop 1\n\t"
                                         "v_add_f32_dpp %0, %0, %0 row_shr:1 row_mask:0xf bank_mask:0xf bound_ctrl:0\n\tv_add_f32_dpp %1, %1, %1 row_shr:1 row_mask:0xf bank_mask:0xf bound_ctrl:0\n\t"
                                         "v_add_f32_dpp %2, %2, %2 row_shr:1 row_mask:0xf bank_mask:0xf bound_ctrl:0\n\tv_add_f32_dpp %3, %3, %3 row_shr:1 row_mask:0xf bank_mask:0xf bound_ctrl:0\n\t"
                                         "v_add_f32_dpp %0, %0, %0 row_shr:2 row_mask:0xf bank_mask:0xf bound_ctrl:0\n\tv_add_f32_dpp %1, %1, %1 row_shr:2 row_mask:0xf bank_mask:0xf bound_ctrl:0\n\t"
                                         "v_add_f32_dpp %2, %2, %2 row_shr:2 row_mask:0xf bank_mask:0xf bound_ctrl:0\n\tv_add_f32_dpp %3, %3, %3 row_shr:2 row_mask:0xf bank_mask:0xf bound_ctrl:0\n\t"
                                         "v_add_f32_dpp %0, %0, %0 row_shr:4 row_mask:0xf bank_mask:0xf bound_ctrl:0\n\tv_add_f32_dpp %1, %1, %1 row_shr:4 row_mask:0xf bank_mask:0xf bound_ctrl:0\n\t"
                                         "v_add_f32_dpp %2, %2, %2 row_shr:4 row_mask:0xf bank_mask:0xf bound_ctrl:0\n\tv_add_f32_dpp %3, %3, %3 row_shr:4 row_mask:0xf bank_mask:0xf bound_ctrl:0\n\t"
                                         "v_add_f32_dpp %0, %0, %0 row_shr:8 row_mask:0xf bank_mask:0xf bound_ctrl:0\n\tv_add_f32_dpp %1, %1, %1 row_shr:8 row_mask:0xf bank_mask:0xf bound_ctrl:0\n\t"
                                         "v_add_f32_dpp %2, %2, %2 row_shr:8 row_mask:0xf bank_mask:0xf bound_ctrl:0\n\tv_add_f32_dpp %3, %3, %3 row_shr:8 row_mask:0xf bank_mask:0xf bound_ctrl:0\n\t"
                                         "s_nop 1"
                                         : "+v"(s0), "+v"(s1), "+v"(s2), "+v"(s3));
                            const f32x4 sc = {s0, s1, s2, s3};
                            f32x4 tt;
                            tt[0] = __builtin_bit_cast(float, __builtin_amdgcn_ds_bpermute(l15, __builtin_bit_cast(int, s0))); tt[1] = __builtin_bit_cast(float, __builtin_amdgcn_ds_bpermute(l15, __builtin_bit_cast(int, s1)));
                            tt[2] = __builtin_bit_cast(float, __builtin_amdgcn_ds_bpermute(l15, __builtin_bit_cast(int, s2))); tt[3] = __builtin_bit_cast(float, __builtin_amdgcn_ds_bpermute(l15, __builtin_bit_cast(int, s3)));
                            *(f32x4*)(LA + (size_t)(row0 + ai * HALF + m * 16) * 512 + (pn - 18) * 256 + bj * HALF + colw + 4 * n) = sc + carry;
                            carry = carry + tt;
                        }
                    }
        } else {
            const int mode = pn < 14 ? 0 : (pn < 18 ? 1 : 2);
            const float post = (pn == 6 || pn == 7) ? QB_SCALE : 1.0f;
#pragma unroll
            for (int ai = 0; ai < 2; ++ai)
#pragma unroll
                for (int m = 0; m < 4; ++m) {
                    const int row = row0 + ai * HALF + m * 16;
                    const float sc = rs[ai][m] * post, sce = rs[ai][m] * -LOG2E;
                    f32x4 v[2][2];
#pragma unroll
                    for (int bj = 0; bj < 2; ++bj)
#pragma unroll
                        for (int n = 0; n < 2; ++n) {
                            if (mode == 0) v[bj][n] = acc[ai][bj][m][n] * sc;
                            else {
#pragma unroll
                                for (int i = 0; i < 4; ++i) { const float a = acc[ai][bj][m][n][i], sg = __builtin_amdgcn_rcpf(1.0f + __builtin_amdgcn_exp2f(a * sce)); v[bj][n][i] = mode == 1 ? (a * sc) * sg : sg; }
                            }
                        }
                    bf16_t* rowp = Z + (size_t)row * NZ + pn * BM + colw;
#pragma unroll
                    for (int bj = 0; bj < 2; ++bj) *(u32x4*)(rowp + bj * HALF) = pack8(v[bj][0], v[bj][1]);
                }
        }
    }
};
struct EpiMix {
    static constexpr bool PERM = true, AFTER_DRAIN = false; static __device__ __forceinline__ bool keeps_acc(const Unit& u) { return u.seg == 0; }
    bf16_t* O; const bf16_t* GA; const bf16_t* GB;
    __device__ __forceinline__ void operator()(f32x4 (&acc)[2][2][4][2], const Unit& u, int wr, int wc, int fr, int fq) const {
        const int row0 = u.pm * BM + wr * 64 + fr, col0 = u.pn * BM + wc * 32 + 8 * fq;
        if (u.seg == 0) {
#pragma unroll
            for (int ai = 0; ai < 2; ++ai)
#pragma unroll
                for (int mb = 0; mb < 4; mb += 2) {
                    u32x4 ga[2][2], gb[2][2];
#pragma unroll
                    for (int mm = 0; mm < 2; ++mm)
#pragma unroll
                        for (int bj = 0; bj < 2; ++bj) { const size_t off = (size_t)(row0 + ai * HALF + (mb + mm) * 16) * NZ + col0 + bj * HALF; ga[mm][bj] = *(const u32x4*)(GA + off); gb[mm][bj] = *(const u32x4*)(GB + off); }
#pragma unroll
                    for (int mm = 0; mm < 2; ++mm)
#pragma unroll
                        for (int bj = 0; bj < 2; ++bj) { const int m = mb + mm;
                            const f32x4 a0 = unlo(ga[mm][bj]), a1 = unhi(ga[mm][bj]), b0 = unlo(gb[mm][bj]), b1 = unhi(gb[mm][bj]);
#pragma unroll
                            for (int i = 0; i < 4; ++i) { const float t0 = __uint_as_float(cvt_pk_bf16(acc[ai][bj][m][0][i] * a0[i], 0.f) << 16), t1 = __uint_as_float(cvt_pk_bf16(acc[ai][bj][m][1][i] * a1[i], 0.f) << 16); acc[ai][bj][m][0][i] = t0 * __builtin_amdgcn_rcpf(fmaxf(b0[i], 1e-20f)); acc[ai][bj][m][1][i] = t1 * __builtin_amdgcn_rcpf(fmaxf(b1[i], 1e-20f)); } }
                }
        } else {
            u32x4 gba[2][4][2];
#pragma unroll
            for (int ai = 0; ai < 2; ++ai)
#pragma unroll
                for (int m = 0; m < 4; ++m)
#pragma unroll
                    for (int bj = 0; bj < 2; ++bj) gba[ai][m][bj] = *(const u32x4*)(GB + (size_t)(row0 + ai * HALF + m * 16) * NZ + col0 + bj * HALF);
            asm volatile("" ::: "memory");
#pragma unroll
            for (int ai = 0; ai < 2; ++ai) {
                const u32x4 (&gb)[4][2] = gba[ai];
#pragma unroll
                for (int m = 0; m < 4; ++m)
#pragma unroll
                    for (int bj = 0; bj < 2; ++bj) *(u32x4*)(O + (size_t)(row0 + ai * HALF + m * 16) * 2048 + col0 + bj * HALF) = pack8(acc[ai][bj][m][0] * unlo(gb[m][bj]), acc[ai][bj][m][1] * unhi(gb[m][bj]));
                asm volatile("" ::: "memory");
            }
        }
    }
};
struct EpiRes {
    static constexpr bool PERM = true, AFTER_DRAIN = false; static __device__ __forceinline__ bool keeps_acc(const Unit&) { return false; }
    bf16_t* xb; float* ssq;
    __device__ __forceinline__ void operator()(const f32x4 (&acc)[2][2][4][2], const Unit& u, int wr, int wc, int fr, int fq) const {
        const int row0 = u.pm * BM + wr * 64 + fr, col0 = u.pn * BM + wc * 32 + 8 * fq;
        float sqs[2][4];
        u32x4 rva[2][4][2];
#pragma unroll
        for (int ai = 0; ai < 2; ++ai)
#pragma unroll
            for (int m = 0; m < 4; ++m)
#pragma unroll
                for (int bj = 0; bj < 2; ++bj) rva[ai][m][bj] = *(const u32x4*)(xb + (size_t)(row0 + ai * HALF + m * 16) * 2048 + col0 + bj * HALF);
        asm volatile("" ::: "memory");
#pragma unroll
        for (int ai = 0; ai < 2; ++ai) {
            const u32x4 (&rv)[4][2] = rva[ai];
#pragma unroll
            for (int m = 0; m < 4; ++m) {
                const int row = row0 + ai * HALF + m * 16;
                float sq = 0.0f;
#pragma unroll
                for (int bj = 0; bj < 2; ++bj) {
                    const f32x4 x0 = unlo(rv[m][bj]) + acc[ai][bj][m][0], x1 = unhi(rv[m][bj]) + acc[ai][bj][m][1];
                    sq += ((x0[0] * x0[0] + x0[1] * x0[1]) + (x0[2] * x0[2] + x0[3] * x0[3])) + ((x1[0] * x1[0] + x1[1] * x1[1]) + (x1[2] * x1[2] + x1[3] * x1[3]));
                    *(u32x4*)(xb + (size_t)row * 2048 + col0 + bj * HALF) = pack8(x0, x1);
                }
                sq += __shfl_xor(sq, 16); sq += __shfl_xor(sq, 32);
                sqs[ai][m] = sq;
            }
            asm volatile("" ::: "memory");
        }
#pragma unroll
        for (int ai = 0; ai < 2; ++ai) { const float v = fq == 0 ? sqs[ai][0] : (fq == 1 ? sqs[ai][1] : (fq == 2 ? sqs[ai][2] : sqs[ai][3]));
            ssq[(size_t)(row0 + ai * HALF + fq * 16) * 32 + u.pn * 4 + wc] = v; }
    }
};
__device__ __forceinline__ unsigned dpp_ror1(unsigned x) { return (unsigned)__builtin_amdgcn_mov_dpp((int)x, 0x121, 0xf, 0xf, false); }
__device__ __forceinline__ unsigned dpp_ror2(unsigned x) { return (unsigned)__builtin_amdgcn_mov_dpp((int)x, 0x122, 0xf, 0xf, false); }
__device__ __forceinline__ unsigned dpp_shr1(unsigned old, unsigned x) { return (unsigned)__builtin_amdgcn_update_dpp((int)old, (int)x, 0x111, 0xf, 0xf, false); }
__device__ __forceinline__ unsigned dpp_shr2(unsigned old, unsigned x) { return (unsigned)__builtin_amdgcn_update_dpp((int)old, (int)x, 0x112, 0xf, 0xf, false); }
typedef unsigned u32x2 __attribute__((ext_vector_type(2)));
typedef _Float16 f16x2_t __attribute__((ext_vector_type(2)));
__device__ __forceinline__ unsigned cvt_pk_f16(float lo, float hi) { const f32x2_t v = {lo, hi}; const f16x2_t h = __builtin_convertvector(v, f16x2_t); return __builtin_bit_cast(unsigned, h); }
__device__ __forceinline__ f16x2_t as_h2(unsigned x) { return __builtin_bit_cast(f16x2_t, x); }
__device__ __forceinline__ unsigned h2_bits(f16x2_t x) { return __builtin_bit_cast(unsigned, x); }
constexpr float LN2 = 0.6931471805599453f;
struct EpiUp {
    static constexpr bool PERM = true, AFTER_DRAIN = false; static __device__ __forceinline__ bool keeps_acc(const Unit&) { return false; }
    bf16_t* ACT; const PG8_LAS float* rsl; PG8_LAS unsigned* xl; PG8_LAS unsigned* cwl; const float* cw; const float* cb; bf16_t* HF; bf16_t* HL;
    __device__ __forceinline__ void operator()(const f32x4 (&acc)[2][2][4][2], const Unit& u, int wr, int wc, int fr, int fq) const {
        const int pn = u.pn, row0 = u.pm * BM + wr * 64 + fr, colw = wc * 32 + 8 * fq, c0 = 128 * pn + colw;
        {
            const int t = (wr * 4 + wc) * 64 + fq * 16 + fr, kind = t >> 6, cc = 2 * (t & 63), gu = kind >> 2, j = kind & 3;
            const float* src = (j < 3 ? cw + (size_t)j * 11264 : cb) + gu * 5632 + 128 * pn + cc;
            const float sc = gu == 0 ? -LOG2E : -LN2;
            cwl[t] = cvt_pk_f16(src[0] * sc, src[1] * sc);
        }
        u32x2 hp[2][2][4][2];
#pragma unroll
        for (int ai = 0; ai < 2; ++ai)
#pragma unroll
            for (int m = 0; m < 4; ++m) { const float rs = rsl[(row0 + ai * HALF + m * 16) & 2047];
#pragma unroll
                for (int gu = 0; gu < 2; ++gu)
#pragma unroll
                    for (int n = 0; n < 2; ++n) { const f32x4 v = acc[ai][gu][m][n] * rs; hp[ai][gu][m][n].x = cvt_pk_f16(v[0], v[1]); hp[ai][gu][m][n].y = cvt_pk_f16(v[2], v[3]); } }
        if (fr >= 14) {
#pragma unroll
            for (int ai = 0; ai < 2; ++ai)
#pragma unroll
                for (int gu = 0; gu < 2; ++gu)
#pragma unroll
                    for (int n = 0; n < 2; ++n) { *(PG8_LAS u32x2*)(xl + ((((2 * ai + wr) * 2 + (fr - 14)) * 256 + 128 * gu + colw + 4 * n) >> 1)) = hp[ai][gu][3][n];
                        if (ai == 1 && wr == 1) *(u32x2*)(HL + (size_t)(u.pm * 2 + fr - 14) * 11264 + pn * 256 + 128 * gu + colw + 4 * n) = hp[1][gu][3][n]; }
        }
        if (wr == 0 && fr < 2) {
#pragma unroll
            for (int gu = 0; gu < 2; ++gu)
#pragma unroll
                for (int n = 0; n < 2; ++n) *(u32x2*)(HF + (size_t)(u.pm * 2 + fr) * 11264 + pn * 256 + 128 * gu + colw + 4 * n) = hp[0][gu][0][n];
        }
        asm volatile("s_waitcnt lgkmcnt(0)" ::: "memory"); __builtin_amdgcn_s_barrier(); asm volatile("" ::: "memory");
#pragma unroll
        for (int ai = 0; ai < 2; ++ai) {
            const bool hasp = (ai == 1) || (wr == 1); const int qp = 2 * ai + wr - 1;
#pragma unroll
            for (int m = 0; m < 4; ++m) {
                f32x4 ov[2];
#pragma unroll
                for (int n = 0; n < 2; ++n) {
                    u32x2 cv[2];
#pragma unroll
                    for (int gu = 0; gu < 2; ++gu) {
                        const PG8_LAS u32x2* cp = (const PG8_LAS u32x2*)(cwl + gu * 256 + ((colw + 4 * n) >> 1));
                        const u32x2 w0 = cp[0], w1 = cp[32], w2 = cp[64], bb = cp[96];
                        const u32x2 hc = hp[ai][gu][m][n];
                        u32x2 o1, o2;
                        if (m > 0) { const u32x2 q = hp[ai][gu][m > 0 ? m - 1 : 0][n]; o1.x = dpp_ror1(q.x); o1.y = dpp_ror1(q.y); o2.x = dpp_ror2(q.x); o2.y = dpp_ror2(q.y); }
                        else if (hasp) { const u32x2 p1 = *(const PG8_LAS u32x2*)(xl + (((qp * 2 + 1) * 256 + 128 * gu + colw + 4 * n) >> 1)), p2 = *(const PG8_LAS u32x2*)(xl + (((qp * 2 + 0) * 256 + 128 * gu + colw + 4 * n) >> 1));
                            o1 = p1; o2.x = fr == 0 ? p2.x : p1.x; o2.y = fr == 0 ? p2.y : p1.y; }
                        else { o1 = (u32x2){0u, 0u}; o2 = o1; }
                        u32x2 s1, s2; s1.x = dpp_shr1(o1.x, hc.x); s1.y = dpp_shr1(o1.y, hc.y); s2.x = dpp_shr2(o2.x, hc.x); s2.y = dpp_shr2(o2.y, hc.y);
                        cv[gu].x = h2_bits(as_h2(w0.x) * as_h2(s2.x) + (as_h2(w1.x) * as_h2(s1.x) + (as_h2(w2.x) * as_h2(hc.x) + as_h2(bb.x))));
                        cv[gu].y = h2_bits(as_h2(w0.y) * as_h2(s2.y) + (as_h2(w1.y) * as_h2(s1.y) + (as_h2(w2.y) * as_h2(hc.y) + as_h2(bb.y))));
                    }
                    const f16x2_t g0 = as_h2(cv[0].x), g1 = as_h2(cv[0].y), p0 = g0 * as_h2(cv[1].x), p1 = g1 * as_h2(cv[1].y);
                    ov[n][0] = (float)p0[0] * __builtin_amdgcn_rcpf(1.0f + __builtin_amdgcn_exp2f((float)g0[0]));
                    ov[n][1] = (float)p0[1] * __builtin_amdgcn_rcpf(1.0f + __builtin_amdgcn_exp2f((float)g0[1]));
                    ov[n][2] = (float)p1[0] * __builtin_amdgcn_rcpf(1.0f + __builtin_amdgcn_exp2f((float)g1[0]));
                    ov[n][3] = (float)p1[1] * __builtin_amdgcn_rcpf(1.0f + __builtin_amdgcn_exp2f((float)g1[1]));
                }
                *(u32x4*)(ACT + (size_t)(row0 + ai * HALF + m * 16) * 5632 + c0) = pack8(ov[0], ov[1]);
            }
        }
    }
};
template <class Epi, class Sched, bool ALIGN_EPI = false, bool SP2 = false>
__device__ __forceinline__ void gemm_phase(PG8_LAS unsigned char* lds, const Gemm g, const Sched& S, const Epi& E, const int tid) {
    const int wid = __builtin_amdgcn_readfirstlane(tid >> 6), lane = tid & 63, wr = wid >> 2, wc = wid & 3, fr = lane & 15, fq = lane >> 4;
    const int K = g.K, nt = K / BK, lda = g.lda;
    unsigned voffA[2], voffB[2];
#pragma unroll
    for (int i = 0; i < 2; ++i) { int R, C; stage_rc(tid * 16 + i * 8192, R, C); const int Rb = Epi::PERM ? ((R & ~31) + perm32(R & 31)) : R;
        voffA[i] = (unsigned)(R * lda + C) * 2u; voffB[i] = (unsigned)(Rb * K + C) * 2u; }
    const size_t kstep = (size_t)(BK * 2);
    const size_t hA = (size_t)HALF * lda * 2, hB = (size_t)HALF * K * 2;
    const size_t tA = 2 * hA, tB = 2 * hB;
    const unsigned ldsw = (unsigned)wid * 1024u;
    const int aoff = lds_byte(wr * 64 + fr, fq * 8), boff = lds_byte(wc * 32 + fr, fq * 8);
#define PG8_SA(b, h) (((b) * 2 + (h)) * HTB)
#define PG8_SB(b, h) ((4 + (b) * 2 + (h)) * HTB)
#define PG8_STAGE(bufoff, gbase, voff) do { _Pragma("unroll") for (int _i = 0; _i < 2; ++_i) \
        __builtin_amdgcn_global_load_lds((const unsigned*)((const char*)(gbase) + (voff)[_i]), (PG8_LAS unsigned*)(lds + (bufoff) + ldsw + _i * 8192), 16, 0, 0); } while (0)
#define PG8_LDA(dst, b, h) do { _Pragma("unroll") for (int m = 0; m < 4; ++m) _Pragma("unroll") for (int k = 0; k < 2; ++k) dst[m][k] = *(const PG8_LAS bf16x8*)(lds + PG8_SA(b, h) + aoff + m * 2048 + k * 1024); } while (0)
#define PG8_LDB(dst, b, h) do { _Pragma("unroll") for (int n = 0; n < 2; ++n) _Pragma("unroll") for (int k = 0; k < 2; ++k) dst[n][k] = *(const PG8_LAS bf16x8*)(lds + PG8_SB(b, h) + boff + n * 2048 + k * 1024); } while (0)
#define PG8_MMA(ai, bj, At, Bt) do { __builtin_amdgcn_s_setprio(1); _Pragma("unroll") for (int m = 0; m < 4; ++m) _Pragma("unroll") for (int n = 0; n < 2; ++n) _Pragma("unroll") for (int k = 0; k < 2; ++k) \
        acc[ai][bj][m][n] = __builtin_amdgcn_mfma_f32_16x16x32_bf16(Bt[n][k], At[m][k], acc[ai][bj][m][n], 0, 0, 0); __builtin_amdgcn_s_setprio(0); } while (0)
#define PG8_WAIT_V(n) asm volatile("s_waitcnt vmcnt(" #n ")" ::: "memory")
#define PG8_WAIT_L(n) asm volatile("s_waitcnt lgkmcnt(" #n ")" ::: "memory")
#define PG8_BAR __builtin_amdgcn_s_barrier()
#define PG8_SCHED __builtin_amdgcn_sched_barrier(0)
    Unit cur, nxt; int ui = 0;
    if (!S.next(0, cur)) return;
    f32x4 acc[2][2][4][2];
#pragma unroll
    for (int a = 0; a < 2; ++a)
#pragma unroll
        for (int b = 0; b < 2; ++b)
#pragma unroll
            for (int m = 0; m < 4; ++m)
#pragma unroll
                for (int n = 0; n < 2; ++n) acc[a][b][m][n] = (f32x4){0.f, 0.f, 0.f, 0.f};
    bf16x8 At[4][2], B0[2][2], B1[2][2];
    const char* cA = (const char*)(cur.seg ? g.A1 : g.A) + (size_t)cur.pm * tA; const char* cB = (const char*)(cur.seg ? g.Bt1 : g.Bt) + (size_t)cur.pn * tB;
    S.a_ready(cur);
    if constexpr (SP2) {
        PG8_STAGE(PG8_SB(0, 0), cB, voffB); PG8_STAGE(PG8_SB(0, 1), cB + hB, voffB); PG8_STAGE(PG8_SA(0, 0), cA, voffA); PG8_STAGE(PG8_SA(0, 1), cA + hA, voffA);
        if (wr == 1) PG8_BAR;
        PG8_WAIT_V(2); PG8_BAR;
        PG8_STAGE(PG8_SB(1, 0), cB + kstep, voffB); PG8_STAGE(PG8_SA(1, 0), cA + kstep, voffA); PG8_STAGE(PG8_SB(1, 1), cB + hB + kstep, voffB);
        PG8_WAIT_V(6); PG8_BAR;
    } else {
        PG8_STAGE(PG8_SB(0, 0), cB, voffB); PG8_STAGE(PG8_SA(0, 0), cA, voffA); PG8_STAGE(PG8_SB(0, 1), cB + hB, voffB); PG8_STAGE(PG8_SA(0, 1), cA + hA, voffA);
        if (wr == 1) PG8_BAR;
        PG8_WAIT_V(4); PG8_BAR;
        PG8_STAGE(PG8_SB(1, 0), cB + kstep, voffB); PG8_STAGE(PG8_SA(1, 0), cA + kstep, voffA); PG8_STAGE(PG8_SB(1, 1), cB + hB + kstep, voffB);
        PG8_WAIT_V(6); PG8_BAR;
    }
    for (;;) {
        const bool has_next = S.next(ui + 1, nxt);
        const char* nA = has_next ? (const char*)(nxt.seg ? g.A1 : g.A) + (size_t)nxt.pm * tA : cA; const char* nB = has_next ? (const char*)(nxt.seg ? g.Bt1 : g.Bt) + (size_t)nxt.pn * tB : cB;
        for (int t = 0; t < nt; t += 2) {
            const bool last = (t == nt - 2);
            const char* a1 = cA + (size_t)(t + 1) * kstep;
            const char* a2 = last ? nA : cA + (size_t)(t + 2) * kstep; const char* b2 = last ? nB : cB + (size_t)(t + 2) * kstep;
            const char* a3 = a2 + kstep; const char* b3 = b2 + kstep;
            if (last && has_next) S.a_ready(nxt);
            if constexpr (SP2) {
            PG8_LDB(B0, 0, 0); PG8_LDB(B1, 0, 1); PG8_SCHED; PG8_LDA(At, 0, 0); PG8_STAGE(PG8_SA(1, 1), a1 + hA, voffA);
            PG8_WAIT_V(8); PG8_WAIT_L(0); PG8_BAR; PG8_MMA(0, 0, At, B0); PG8_MMA(0, 1, At, B1); PG8_BAR; PG8_SCHED;
            PG8_LDA(At, 0, 1); PG8_STAGE(PG8_SB(0, 0), b2, voffB); PG8_STAGE(PG8_SB(0, 1), b2 + hB, voffB); PG8_STAGE(PG8_SA(0, 0), a2, voffA);
            PG8_WAIT_V(8); PG8_WAIT_L(0); PG8_BAR; PG8_MMA(1, 0, At, B0); PG8_MMA(1, 1, At, B1); PG8_BAR; PG8_SCHED;
            PG8_LDB(B0, 1, 0); PG8_LDB(B1, 1, 1); PG8_SCHED; PG8_LDA(At, 1, 0); PG8_STAGE(PG8_SA(0, 1), a2 + hA, voffA);
            PG8_WAIT_V(8); PG8_WAIT_L(0); PG8_BAR; PG8_MMA(0, 0, At, B0); PG8_MMA(0, 1, At, B1); PG8_BAR; PG8_SCHED;
            PG8_LDA(At, 1, 1); PG8_STAGE(PG8_SB(1, 0), b3, voffB); PG8_STAGE(PG8_SB(1, 1), b3 + hB, voffB); PG8_STAGE(PG8_SA(1, 0), a3, voffA);
            PG8_WAIT_V(8); PG8_WAIT_L(0); PG8_BAR; PG8_MMA(1, 0, At, B0); PG8_MMA(1, 1, At, B1); PG8_BAR; PG8_SCHED;
            } else {
            PG8_LDB(B0, 0, 0); PG8_SCHED; PG8_LDA(At, 0, 0); PG8_STAGE(PG8_SA(1, 1), a1 + hA, voffA);
            PG8_WAIT_L(8); PG8_BAR; PG8_WAIT_L(0); PG8_MMA(0, 0, At, B0); PG8_BAR; PG8_SCHED;
            PG8_LDB(B1, 0, 1); PG8_STAGE(PG8_SB(0, 0), b2, voffB);
            PG8_BAR; PG8_WAIT_L(0); PG8_MMA(0, 1, At, B1); PG8_BAR;
            PG8_LDA(At, 0, 1); PG8_STAGE(PG8_SA(0, 0), a2, voffA);
            PG8_BAR; PG8_WAIT_L(0); PG8_MMA(1, 0, At, B0); PG8_BAR; PG8_SCHED;
            PG8_STAGE(PG8_SB(0, 1), b2 + hB, voffB);
            PG8_WAIT_V(6); PG8_BAR; PG8_MMA(1, 1, At, B1); PG8_BAR;
            PG8_LDB(B0, 1, 0); PG8_SCHED; PG8_LDA(At, 1, 0); PG8_STAGE(PG8_SA(0, 1), a2 + hA, voffA);
            PG8_WAIT_L(8); PG8_BAR; PG8_WAIT_L(0); PG8_MMA(0, 0, At, B0); PG8_BAR; PG8_SCHED;
            PG8_LDB(B1, 1, 1); PG8_STAGE(PG8_SB(1, 0), b3, voffB);
            PG8_BAR; PG8_WAIT_L(0); PG8_MMA(0, 1, At, B1); PG8_BAR;
            PG8_LDA(At, 1, 1); PG8_STAGE(PG8_SA(1, 0), a3, voffA);
            PG8_BAR; PG8_WAIT_L(0); PG8_MMA(1, 0, At, B0); PG8_BAR; PG8_SCHED;
            PG8_STAGE(PG8_SB(1, 1), b3 + hB, voffB);
            PG8_WAIT_V(6); PG8_BAR; PG8_MMA(1, 1, At, B1); PG8_BAR;
            }
        }
        if constexpr (ALIGN_EPI) { if (wr == 0) PG8_BAR; }
        if constexpr (!Epi::AFTER_DRAIN) { E(acc, cur, wr, wc, fr, fq); S.done(cur); }
        if (!has_next) break;
        if (!Epi::keeps_acc(cur)) {
#pragma unroll
        for (int a = 0; a < 2; ++a)
#pragma unroll
            for (int b = 0; b < 2; ++b)
#pragma unroll
                for (int m = 0; m < 4; ++m)
#pragma unroll
                    for (int n = 0; n < 2; ++n) acc[a][b][m][n] = (f32x4){0.f, 0.f, 0.f, 0.f};
        }
        cur = nxt; cA = nA; cB = nB; ++ui;
        if constexpr (ALIGN_EPI) { if (wr == 1) PG8_BAR; }
    }
    PG8_WAIT_V(0);
    if constexpr (!ALIGN_EPI) { if (wr == 0) PG8_BAR; }
    PG8_BAR;
    if constexpr (Epi::AFTER_DRAIN) { E.fused(acc, cur, wr, wc, fr, fq, lds, wid, lane); S.done(cur); }
#undef PG8_SA
#undef PG8_SB
#undef PG8_STAGE
#undef PG8_LDA
#undef PG8_LDB
#undef PG8_MMA
#undef PG8_WAIT_V
#undef PG8_WAIT_L
#undef PG8_BAR
#undef PG8_SCHED
}
}
#define GAS __attribute__((address_space(1)))
#define LAS __attribute__((address_space(3)))
typedef unsigned short bf16;
typedef unsigned v4u __attribute__((ext_vector_type(4)));
typedef float f32x4 __attribute__((ext_vector_type(4)));
typedef short bf16x8 __attribute__((ext_vector_type(8)));
typedef GAS unsigned gu32;
typedef GAS unsigned long long gu64;
#define RLX_AGENT __ATOMIC_RELAXED, __HIP_MEMORY_SCOPE_AGENT
#define LDS_WAIT() asm volatile("s_waitcnt lgkmcnt(0)" ::: "memory")
#define VM_WAIT() asm volatile("s_waitcnt vmcnt(0)" ::: "memory")
__device__ __forceinline__ unsigned long long rt() { return __builtin_amdgcn_s_memrealtime(); }
__device__ __forceinline__ unsigned f2bf(float f) { unsigned u = __builtin_bit_cast(unsigned, f); return (u + 0x7fffu + ((u >> 16) & 1u)) >> 16; }
__device__ __forceinline__ unsigned pk2(float lo, float hi) { return f2bf(lo) | (f2bf(hi) << 16); }

#define XB_TMO      128
#define XB_XCNT(j)  (256  + 64 * (j))
#define XB_XSUB(j)  (1280 + 64 * (j))
#define XB_XGEN(j)  (2304 + 64 * (j))
#define XB_TOP      3328
#define XB_TOPGEN   3392
#define XCD_BAR_WORDS 3456
#define XB_SPIN_CAP (1u << 18)

__device__ __forceinline__ unsigned xb_ld(unsigned* p)              { return __hip_atomic_load(p, __ATOMIC_RELAXED, __HIP_MEMORY_SCOPE_AGENT); }
__device__ __forceinline__ unsigned xb_add(unsigned* p, unsigned v) { return __hip_atomic_fetch_add(p, v, __ATOMIC_RELAXED, __HIP_MEMORY_SCOPE_AGENT); }
__device__ __forceinline__ unsigned xb_xcc_id() { return (unsigned)__builtin_amdgcn_s_getreg((3 << 11) | 20) & 0xFu; }
#define XB_SPIN(cond, bar) do { unsigned _sp = 0; while (cond) { __builtin_amdgcn_s_sleep(1); \
    if ((++_sp & 255u) == 0u) { if (xb_ld(&(bar)[XB_TMO])) break; if (_sp > XB_SPIN_CAP) { atomicAdd(&(bar)[XB_TMO], 1u); break; } } } } while (0)

struct XcdBarrier {
    unsigned* bar; unsigned x;
    volatile LAS unsigned* st;
};

__device__ __forceinline__ XcdBarrier xcd_barrier_post(unsigned* bar, volatile LAS unsigned* st) {
    XcdBarrier b; b.bar = bar; b.x = xb_xcc_id(); b.st = st;
    if (threadIdx.x == 0) (void)xb_add(&bar[XB_XCNT(b.x)], 1u);
    return b;
}
__device__ __forceinline__ void xcd_barrier_complete(unsigned* bar, unsigned x, unsigned& nloc, unsigned& nx) {
    const unsigned G = gridDim.x * gridDim.y * gridDim.z;
    unsigned sum, cnt, mine, sp = 0u;
    for (;;) {
        sum = 0u; cnt = 0u; mine = 0u;
#pragma unroll
        for (unsigned j = 0; j < 16; ++j) { const unsigned c = xb_ld(&bar[XB_XCNT(j)]); sum += c; cnt += (c > 0u) ? 1u : 0u; mine = (j == x) ? c : mine; }
        if (sum == G) break;
        __builtin_amdgcn_s_sleep(1);
        if ((++sp & 255u) == 0u) { if (xb_ld(&bar[XB_TMO])) break; if (sp > XB_SPIN_CAP) { atomicAdd(&bar[XB_TMO], 1u); break; } }
    }
    nloc = mine > 0u ? mine : 1u; nx = cnt > 0u ? cnt : 1u;
}

__device__ __forceinline__ void xcd_barrier(const XcdBarrier& b) {
    asm volatile("s_waitcnt vmcnt(0)" ::: "memory");
    __syncthreads();
    if (threadIdx.x == 0) {
        unsigned* bar = b.bar;
        __builtin_amdgcn_s_waitcnt(0);
        unsigned nloc = b.st[0], nx = b.st[1];
        if (nloc == 0u) { xcd_barrier_complete(bar, b.x, nloc, nx); b.st[0] = nloc; b.st[1] = nx; }
        const unsigned old = xb_add(&bar[XB_XSUB(b.x)], 1u);
        const unsigned gen = old / nloc;
        if (old + 1u == (gen + 1u) * nloc) {
            __builtin_amdgcn_fence(__ATOMIC_RELEASE, "agent");
            asm volatile("s_waitcnt vmcnt(0)" ::: "memory");
            const unsigned og = xb_add(&bar[XB_TOP], 1u);
            const unsigned tg = og / nx;
            if (og + 1u == (tg + 1u) * nx) xb_add(&bar[XB_TOPGEN], 1u);
            else XB_SPIN(xb_ld(&bar[XB_TOPGEN]) == tg, bar);
            __builtin_amdgcn_fence(__ATOMIC_ACQUIRE, "agent");
            xb_add(&bar[XB_XGEN(b.x)], 1u);
            asm volatile("s_waitcnt vmcnt(0)" ::: "memory");
        } else {
            XB_SPIN(xb_ld(&bar[XB_XGEN(b.x)]) == gen, bar);
            __builtin_amdgcn_fence(__ATOMIC_ACQUIRE, "agent");
            asm volatile("s_waitcnt vmcnt(0)" ::: "memory");
        }
    }
    __syncthreads();
}
typedef unsigned v2u __attribute__((ext_vector_type(2)));
typedef float v2f __attribute__((ext_vector_type(2)));

constexpr int NWAVES = 8;
constexpr int M = 16384, DM = 2048, SEQ = 2048, DFF = 5632, NH = 11264, WIN_LD = 8720;
using pg8::NZ; using pg8::ZQA; using pg8::ZKA; using pg8::ZVA; using pg8::ZQB; using pg8::ZKB; using pg8::ZVB; using pg8::ZRB; using pg8::ZAL; using pg8::ZGA; using pg8::ZGB;
constexpr int N_PHASES = 19;
constexpr size_t MiB = 1u << 20;
constexpr size_t WS_CTL = 0, CTL_ZERO_BYTES = 1 * MiB;
constexpr size_t WS_SSQ = 1 * MiB;
constexpr size_t WS_ROPE = 3 * MiB;
constexpr size_t WS_ONES = 4 * MiB;
constexpr size_t WS_WUP = 8 * MiB;
constexpr size_t WS_WDN = 52 * MiB;
constexpr size_t WS_XB = 74 * MiB;
constexpr size_t WS_WIN = 138 * MiB;
constexpr size_t WS_WA = 174 * MiB, WS_WB = 178 * MiB;
constexpr size_t WS_WO = 182 * MiB;
constexpr size_t WS_ZB = 190 * MiB;
constexpr size_t WS_LA = 478 * MiB;
constexpr size_t WS_Y = 510 * MiB;
constexpr size_t WS_MIX = 574 * MiB;
constexpr size_t WS_HF = 190 * MiB, WS_HL = 198 * MiB;
constexpr size_t WS_ACT = 490 * MiB;
constexpr size_t WS_END = 666 * MiB;
static_assert(WS_HL + (size_t)64 * 2 * NH * 4 <= WS_ACT && WS_ACT + (size_t)M * DFF * 2 <= WS_END && WS_MIX + (size_t)M * DM * 2 <= WS_END && WS_ZB + (size_t)M * NZ * 2 <= WS_LA, "ws map");
constexpr int CW_BAR = 4096;
constexpr int RING_OFF = 0, RING_BYTES = 131072;
constexpr int LDSCTL_OFF = RING_BYTES, MISC_OFF = LDSCTL_OFF + 320;
constexpr int RSTAB_OFF = LDSCTL_OFF + 1024;
constexpr int XL_OFF = RSTAB_OFF + 8192;
constexpr int CWL_OFF = XL_OFF + 8192;
constexpr int LDS_BYTES = 163840;
static_assert(CWL_OFF + 4096 <= LDS_BYTES, "LDS map");

__device__ __forceinline__ float wave_sum(float v) {
#pragma unroll
    for (int o = 1; o < 64; o <<= 1) v += __shfl_xor(v, o);
    return v;
}
__device__ __forceinline__ float wave_max(float v) {
#pragma unroll
    for (int o = 1; o < 64; o <<= 1) v = fmaxf(v, __shfl_xor(v, o));
    return v;
}
__device__ __forceinline__ float bf2f(bf16 b) { return __uint_as_float(((unsigned)b) << 16); }
__device__ __forceinline__ float bflo(unsigned w) { return __uint_as_float(w << 16); }
__device__ __forceinline__ float bfhi(unsigned w) { return __uint_as_float(w & 0xffff0000u); }
__device__ __forceinline__ void un8h(v4u w, float (&f)[8]) { const pg8::f16x2_t a = pg8::as_h2(w.x), b = pg8::as_h2(w.y), c = pg8::as_h2(w.z), d = pg8::as_h2(w.w); f[0] = (float)a[0]; f[1] = (float)a[1]; f[2] = (float)b[0]; f[3] = (float)b[1]; f[4] = (float)c[0]; f[5] = (float)c[1]; f[6] = (float)d[0]; f[7] = (float)d[1]; }
__device__ __forceinline__ void un8(v4u w, float (&f)[8]) { f[0] = bflo(w.x); f[1] = bfhi(w.x); f[2] = bflo(w.y); f[3] = bfhi(w.y); f[4] = bflo(w.z); f[5] = bfhi(w.z); f[6] = bflo(w.w); f[7] = bfhi(w.w); }
using pg8::cvt_pk_bf16;
__device__ const double ROPE_INVF[8] = {1.0, 0.19392274474868576, 0.03760603093086393, 0.007292664737217109, 0.001414213562373095, 0.0002742481756762073, 5.318295896944988e-05, 1.031338537721246e-05};

__device__ __forceinline__ void alpha_item(const float* Win, const float* Wau, const float* gk, int k0, int j0, bf16* WT, LAS float* scr, int lane) {
    const int jj = lane & 31;
    float wa[16];
#pragma unroll
    for (int r = 0; r < 16; ++r) wa[r] = Wau[r * 512 + j0 + jj];
#pragma unroll 4
    for (int i = 0; i < 32; ++i) { const int kk = 2 * i + (lane >> 5); const float* wr = Win + (size_t)(k0 + kk) * WIN_LD + 4608; float s = 0.f;
#pragma unroll
        for (int r = 0; r < 16; ++r) s += wr[r] * wa[r];
        scr[kk * 33 + jj] = s * gk[k0 + kk]; }
    LDS_WAIT(); asm volatile("" ::: "memory");
    const int c = lane & 7;
#pragma unroll
    for (int j = 0; j < 4; ++j) { const int n = (lane >> 3) + 8 * j; const LAS float* s = scr + (8 * c) * 33 + n;
        v4u o; o.x = cvt_pk_bf16(s[0 * 33], s[1 * 33]); o.y = cvt_pk_bf16(s[2 * 33], s[3 * 33]); o.z = cvt_pk_bf16(s[4 * 33], s[5 * 33]); o.w = cvt_pk_bf16(s[6 * 33], s[7 * 33]);
        *(GAS v4u*)(WT + (size_t)(ZAL + j0 + n) * DM + k0 + 8 * c) = o; }
    LDS_WAIT(); asm volatile("" ::: "memory");
}


__device__ __forceinline__ void fill_rstd_table(const float* ssq, LAS unsigned char* lds, int tid) {
    const int base = 2048 * ((int)blockIdx.x & 7);
#pragma unroll
    for (int i = 0; i < 4; ++i) { const int r = tid + 512 * i; const GAS f32x4* p = (const GAS f32x4*)(ssq + (size_t)(base + r) * 32);
        f32x4 a = p[0];
#pragma unroll
        for (int q = 1; q < 8; ++q) a = a + p[q];
        ((LAS float*)(lds + RSTAB_OFF))[r] = 1.0f / sqrtf(((a[0] + a[1]) + (a[2] + a[3])) * (1.0f / 2048.0f) + pg8::RMS_EPS); }
    __syncthreads();
}

struct Args { const void* in[17]; float* out; unsigned char* ws; int ph_lo, ph_hi; };
typedef const __attribute__((address_space(4))) Args* ArgsK;
struct LayerIn { const float *gmix, *win, *sink, *wau, *balpha, *ggla, *wa, *wb, *wo, *gffn, *wup, *cw, *cb, *wdn; };

struct TItem { const float* src; const float* gk; bf16* dst; int ldw, ldt; };
constexpr int I_IN = 272 * 32, I_A = 64 * 16, I_O = 64 * 32, I_UP = 352 * 32, I_DN = 64 * 88, I_AL = 16 * 32;
constexpr int NS_ITEMS = 2 * I_A + I_O + I_UP + I_DN;
__device__ __forceinline__ TItem decode_win(const float* win, const float* gmix, unsigned char* ws, int r) {
    TItem t; const int kb = r / 272, nb = r % 272; const int n0 = nb < 144 ? nb * 32 : 5120 + (nb - 144) * 32; const int c0 = n0 < 4608 ? n0 : n0 - 496;
    t.src = win + (size_t)(kb * 64) * WIN_LD + c0; t.gk = gmix + kb * 64; t.dst = (bf16*)(ws + WS_WIN) + (size_t)n0 * DM + kb * 64; t.ldw = WIN_LD; t.ldt = DM; return t;
}
__device__ __forceinline__ TItem decode_side(const LayerIn& L, unsigned char* ws, int it) {
    TItem t; int r = it;
    if (r < I_A) { const int kb = r / 64, nb = r % 64; t.src = L.wa + (size_t)(kb * 64) * DM + nb * 32; t.gk = nullptr; t.dst = (bf16*)(ws + WS_WA) + (size_t)(nb * 32) * 1024 + kb * 64; t.ldw = DM; t.ldt = 1024; return t; } r -= I_A;
    if (r < I_A) { const int kb = r / 64, nb = r % 64; t.src = L.wb + (size_t)(kb * 64) * DM + nb * 32; t.gk = nullptr; t.dst = (bf16*)(ws + WS_WB) + (size_t)(nb * 32) * 1024 + kb * 64; t.ldw = DM; t.ldt = 1024; return t; } r -= I_A;
    if (r < I_O) { const int kb = r / 64, nb = r % 64; t.src = L.wo + (size_t)(kb * 64) * DM + nb * 32; t.gk = nullptr; t.dst = (bf16*)(ws + WS_WO) + (size_t)(nb * 32) * DM + kb * 64; t.ldw = DM; t.ldt = DM; return t; } r -= I_O;
    if (r < I_UP) { const int kb = r / 352, nb = r % 352; const int n0 = nb * 32, pn = n0 >> 8, j0 = n0 & 255; const int c0 = j0 < 128 ? 128 * pn + j0 : DFF + 128 * pn + (j0 - 128);
        t.src = L.wup + (size_t)(kb * 64) * NH + c0; t.gk = L.gffn + kb * 64; t.dst = (bf16*)(ws + WS_WUP) + (size_t)n0 * DM + kb * 64; t.ldw = NH; t.ldt = DM; return t; } r -= I_UP;
    { const int kb = r / 64, nb = r % 64; t.src = L.wdn + (size_t)(kb * 64) * DM + nb * 32; t.gk = nullptr; t.dst = (bf16*)(ws + WS_WDN) + (size_t)(nb * 32) * DFF + kb * 64; t.ldw = DM; t.ldt = DFF; return t; }
}
struct SideJob { ArgsK ap; int l; };
__device__ __forceinline__ TItem decode_job(const SideJob& J, unsigned char* ws, int it) {
    const int l = J.l;
    if (it >= NS_ITEMS) return decode_win((const float*)J.ap->in[3] + (size_t)DM * WIN_LD, (const float*)J.ap->in[2] + DM, ws, it - NS_ITEMS);
    LayerIn L;
    L.wa = (const float*)J.ap->in[8] + (size_t)l * 1024 * DM; L.wb = (const float*)J.ap->in[9] + (size_t)l * 1024 * DM; L.wo = (const float*)J.ap->in[10] + (size_t)l * DM * DM;
    L.gffn = (const float*)J.ap->in[11] + (size_t)l * DM; L.wup = (const float*)J.ap->in[12] + (size_t)l * DM * NH; L.wdn = (const float*)J.ap->in[15] + (size_t)l * DFF * DM;
    return decode_side(L, ws, it);
}
__device__ __forceinline__ void titem_load(const TItem& t, int lane, float (&v)[32], f32x4 (&g)[2]) {
    const float* p = t.src + (size_t)(lane >> 5) * t.ldw + (lane & 31);
#pragma unroll
    for (int i = 0; i < 32; ++i) v[i] = p[(size_t)(2 * i) * t.ldw];
    if (t.gk) { g[0] = *(const GAS f32x4*)(t.gk + 8 * (lane & 7)); g[1] = *(const GAS f32x4*)(t.gk + 8 * (lane & 7) + 4); }
    else { g[0] = (f32x4){1.f, 1.f, 1.f, 1.f}; g[1] = g[0]; }
}
__device__ __forceinline__ void titem_store(const TItem& t, int lane, const float (&v)[32], const f32x4 (&g)[2], LAS float* scr) {
#pragma unroll
    for (int i = 0; i < 32; ++i) scr[(2 * i + (lane >> 5)) * 33 + (lane & 31)] = v[i];
    LDS_WAIT(); asm volatile("" ::: "memory");
    const int c = lane & 7;
#pragma unroll
    for (int j = 0; j < 4; ++j) { const int n = (lane >> 3) + 8 * j; const LAS float* s = scr + (8 * c) * 33 + n;
        v4u o; o.x = cvt_pk_bf16(s[0 * 33] * g[0][0], s[1 * 33] * g[0][1]); o.y = cvt_pk_bf16(s[2 * 33] * g[0][2], s[3 * 33] * g[0][3]); o.z = cvt_pk_bf16(s[4 * 33] * g[1][0], s[5 * 33] * g[1][1]); o.w = cvt_pk_bf16(s[6 * 33] * g[1][2], s[7 * 33] * g[1][3]);
        *(GAS v4u*)(t.dst + (size_t)n * t.ldt + 8 * c) = o; }
    LDS_WAIT(); asm volatile("" ::: "memory");
}
__device__ __forceinline__ void phase_weights(const LayerIn& L, unsigned char* ws, LAS unsigned char* lds, int gw, int NGW, int wave, int lane) {
    LAS float* scr = (LAS float*)(lds + RING_OFF + wave * 16384);
    float vA[32], vB[32]; f32x4 gA[2], gB[2]; TItem dA, dB;
    int it = gw;
    if (it < I_IN) { dA = decode_win(L.win, L.gmix, ws, it); titem_load(dA, lane, vA, gA); }
    while (it < I_IN) {
        const int it2 = it + NGW, it3 = it2 + NGW;
        if (it2 < I_IN) { dB = decode_win(L.win, L.gmix, ws, it2); titem_load(dB, lane, vB, gB); }
        titem_store(dA, lane, vA, gA, scr);
        if (it3 < I_IN) { dA = decode_win(L.win, L.gmix, ws, it3); titem_load(dA, lane, vA, gA); }
        if (it2 < I_IN) titem_store(dB, lane, vB, gB, scr);
        it = it3;
    }
    for (int r = gw; r < I_AL; r += NGW) { const int kb = r / 16, jb = r % 16; alpha_item(L.win, L.wau, L.gmix, kb * 64, jb * 32, (bf16*)(ws + WS_WIN), scr, lane); }
}
__device__ __forceinline__ void phase_xprep(const float* x, const int* pos, unsigned char* ws, int gw, int NGW, int lane) {
    bf16* XB = (bf16*)(ws + WS_XB); float* SSQ = (float*)(ws + WS_SSQ); float* CS = (float*)(ws + WS_ROPE);
    if (gw == 0) ((float*)(ws + WS_ONES))[lane] = 1.0f;
    for (int m0 = gw * 2; m0 < M; m0 += NGW * 2) {
        f32x4 v[2][8]; float s[2] = {0.f, 0.f};
#pragma unroll
        for (int k = 0; k < 2; ++k) { const GAS f32x4* xr = (const GAS f32x4*)(x + (size_t)(m0 + k) * DM) + lane;
#pragma unroll
            for (int j = 0; j < 8; ++j) { v[k][j] = xr[64 * j]; s[k] += (v[k][j].x * v[k][j].x + v[k][j].y * v[k][j].y) + (v[k][j].z * v[k][j].z + v[k][j].w * v[k][j].w); } }
#pragma unroll
        for (int off = 1; off < 64; off <<= 1) { s[0] += __shfl_xor(s[0], off); s[1] += __shfl_xor(s[1], off); }
#pragma unroll
        for (int k = 0; k < 2; ++k) { const int m = m0 + k;
            GAS v2u* o8 = (GAS v2u*)(XB + (size_t)m * DM) + lane;
#pragma unroll
            for (int j = 0; j < 8; ++j) { v2u w; w.x = cvt_pk_bf16(v[k][j].x, v[k][j].y); w.y = cvt_pk_bf16(v[k][j].z, v[k][j].w); o8[64 * j] = w; }
            if (lane < 32) SSQ[(size_t)m * 32 + lane] = lane == 0 ? s[k] : 0.f;
            if (lane < 8) {
                const double a = (double)pos[m] * ROPE_INVF[lane] * 0.15915494309189535; const float fr = (float)(a - rint(a));
                v2f cs2; cs2.x = __builtin_amdgcn_cosf(fr); cs2.y = __builtin_amdgcn_sinf(fr); *(GAS v2f*)(CS + (size_t)m * 16 + 2 * lane) = cs2; } }
    }
}

typedef float f32x16 __attribute__((ext_vector_type(16)));
typedef short s16x4 __attribute__((ext_vector_type(4)));
constexpr int SW_PITCH = 144, SW_KOFF = 0, SW_VOFF = 256 * SW_PITCH;
__device__ __forceinline__ s16x4 lds_tr(LAS const unsigned char* p) { return __builtin_bit_cast(s16x4, __builtin_amdgcn_ds_read_tr16_b64_v4i16((LAS s16x4*)p)); }
__device__ __forceinline__ bf16x8 mk8(s16x4 lo, s16x4 hi) { return (bf16x8){lo[0], lo[1], lo[2], lo[3], hi[0], hi[1], hi[2], hi[3]}; }
__device__ __forceinline__ void swa_phase(const bf16* Z, const float* sink, bf16* Y, LAS unsigned char* lds, int tid0, int G) {
    const int wave = __builtin_amdgcn_readfirstlane(tid0 >> 6);
    for (int it = blockIdx.x; it < 512; it += G) {
        int tid = tid0; asm volatile("" : "+v"(tid));
        const int lane = tid & 63, r32 = lane & 31, hh = lane >> 5;
        const int tq = (lane & 15) >> 2, tp = lane & 3, tcb = 16 * ((lane >> 4) & 1);
        const int b = it >> 6, blk = (it >> 2) & 15, hk = it & 3;
        const int r0 = b * SEQ + blk * 128 - 128;
        v4u kv[4], vv[4];
#pragma unroll
        for (int i = 0; i < 4; ++i) { const int c = tid + 512 * i, ki = c >> 3, dc = c & 7;
            if (blk > 0 || ki >= 128) { const bf16* src = Z + (size_t)(r0 + ki) * NZ + hk * 64 + dc * 8; kv[i] = *(const GAS v4u*)(src + ZKA); vv[i] = *(const GAS v4u*)(src + ZVA); }
            else { kv[i] = (v4u){0u, 0u, 0u, 0u}; vv[i] = (v4u){0u, 0u, 0u, 0u}; } }
#pragma unroll
        for (int i = 0; i < 4; ++i) { const int c = tid + 512 * i, ki = c >> 3, dc = c & 7;
            *(LAS v4u*)(lds + SW_KOFF + ki * SW_PITCH + dc * 16) = kv[i]; *(LAS v4u*)(lds + SW_VOFF + ki * SW_PITCH + dc * 16) = vv[i]; }
        __syncthreads();
        const int hq = 4 * hk + (wave >> 1);
        const float sk = sink[hq] * pg8::LOG2E;
#pragma nounroll
        for (int qs = 0; qs < 2; ++qs) {
            const int a = 2 * (wave & 1) + qs, q0 = 32 * a;
            const size_t rowq = (size_t)b * SEQ + blk * 128 + q0 + r32;
            bf16x8 qf[4];
#pragma unroll
            for (int s = 0; s < 4; ++s) qf[s] = *(const GAS bf16x8*)(Z + rowq * NZ + ZQA + hq * 64 + 16 * s + 8 * hh);
            f32x16 sc[5];
#pragma unroll
            for (int j = 0; j < 5; ++j) {
                f32x16 acc = {0.f, 0.f, 0.f, 0.f, 0.f, 0.f, 0.f, 0.f, 0.f, 0.f, 0.f, 0.f, 0.f, 0.f, 0.f, 0.f};
                const LAS unsigned char* kp = lds + SW_KOFF + (32 * (a + j) + r32) * SW_PITCH + 16 * hh;
#pragma unroll
                for (int s = 0; s < 4; ++s) acc = __builtin_amdgcn_mfma_f32_32x32x16_bf16(*(const LAS bf16x8*)(kp + 32 * s), qf[s], acc, 0, 0, 0);
                sc[j] = acc;
            }
            const int qi = q0 + r32;
            float mx = -INFINITY;
#pragma unroll
            for (int j = 0; j < 5; ++j)
#pragma unroll
                for (int rho = 0; rho < 16; ++rho) { const int key = 32 * (a + j) + (rho & 3) + 8 * (rho >> 2) + 4 * hh;
                    const bool ok = (key > qi) && (key <= qi + 128) && (blk > 0 || key >= 128);
                    const float v = ok ? sc[j][rho] : -INFINITY; sc[j][rho] = v; mx = fmaxf(mx, v); }
            mx = fmaxf(mx, __shfl_xor(mx, 32)); mx = fmaxf(mx, sk);
            float ls = 0.f;
#pragma unroll
            for (int j = 0; j < 5; ++j)
#pragma unroll
                for (int rho = 0; rho < 16; ++rho) { const float p = __builtin_amdgcn_exp2f(sc[j][rho] - mx); sc[j][rho] = p; ls += p; }
            ls += __shfl_xor(ls, 32); ls += __builtin_amdgcn_exp2f(sk - mx);
            const float rinv = 1.0f / ls;
            f32x16 oa[2];
            oa[0] = (f32x16){0.f, 0.f, 0.f, 0.f, 0.f, 0.f, 0.f, 0.f, 0.f, 0.f, 0.f, 0.f, 0.f, 0.f, 0.f, 0.f}; oa[1] = oa[0];
#pragma unroll
            for (int j = 0; j < 5; ++j)
#pragma unroll
                for (int s2 = 0; s2 < 2; ++s2) {
                    v4u pw; pw.x = cvt_pk_bf16(sc[j][8 * s2 + 0], sc[j][8 * s2 + 1]); pw.y = cvt_pk_bf16(sc[j][8 * s2 + 2], sc[j][8 * s2 + 3]); pw.z = cvt_pk_bf16(sc[j][8 * s2 + 4], sc[j][8 * s2 + 5]); pw.w = cvt_pk_bf16(sc[j][8 * s2 + 6], sc[j][8 * s2 + 7]);
                    const bf16x8 pf = __builtin_bit_cast(bf16x8, pw);
                    const LAS unsigned char* vp = lds + SW_VOFF + (32 * (a + j) + 16 * s2 + 4 * hh + tq) * SW_PITCH + (tcb + 4 * tp) * 2;
#pragma unroll
                    for (int dt = 0; dt < 2; ++dt) { const bf16x8 vf = mk8(lds_tr(vp + dt * 64), lds_tr(vp + dt * 64 + 8 * SW_PITCH));
                        oa[dt] = __builtin_amdgcn_mfma_f32_32x32x16_bf16(vf, pf, oa[dt], 0, 0, 0); }
                }
            bf16* yp = Y + rowq * DM + hq * 64 + 4 * hh;
#pragma unroll
            for (int dt = 0; dt < 2; ++dt)
#pragma unroll
                for (int gq = 0; gq < 4; ++gq) { v2u w; w.x = cvt_pk_bf16(oa[dt][4 * gq] * rinv, oa[dt][4 * gq + 1] * rinv); w.y = cvt_pk_bf16(oa[dt][4 * gq + 2] * rinv, oa[dt][4 * gq + 3] * rinv);
                    *(GAS v2u*)(yp + 32 * dt + 8 * gq) = w; }
        }
        __syncthreads();
    }
}


constexpr int G2_QD = 0, G2_KI = 34816, G2_KE = 69632, G2_QB = 17408, G2_QP = 272;
constexpr int G2_V = 104448, G2_VB = 5120, G2_VP = 80;
constexpr int G2_ST0 = 114688, G2_ST1 = RSTAB_OFF, G2_SP = 272;
constexpr int G2_BL = 123392;
static_assert(G2_ST0 + 32 * G2_SP <= G2_BL && G2_BL + 1024 <= RING_BYTES && G2_ST1 + 32 * G2_SP <= LDS_BYTES, "GLA LDS map");
#define GLA_BAR() asm volatile("s_waitcnt lgkmcnt(0)\n\ts_barrier" ::: "memory")
struct GlaIn { f32x4 b[2][4]; v4u q[2][2], k[2][2], v; };
__device__ __forceinline__ void gla_load(GlaIn& I, const bf16* Z, const float* LA, size_t R0, int h, int es, int pt) {
    const int prow = pt >> 3, pdc = pt & 7;
#pragma unroll
    for (int r = 0; r < 2; ++r) {
        const float* bp = LA + (R0 + prow + 32 * r) * 512 + h * 128 + 8 * pdc; const bf16* zr = Z + (R0 + prow + 32 * r) * NZ + h * 128 + 8 * pdc;
#pragma unroll
        for (int i = 0; i < 2; ++i) { I.b[r][2 * i] = *(const GAS f32x4*)(bp + 64 * i); I.b[r][2 * i + 1] = *(const GAS f32x4*)(bp + 64 * i + 4); I.q[r][i] = *(const GAS v4u*)(zr + ZQB + 64 * i); I.k[r][i] = *(const GAS v4u*)(zr + ZKB + 64 * i); }
    }
    I.v = *(const GAS v4u*)(Z + (R0 + (pt >> 2)) * NZ + ZVB + h * 256 + es * 32 + (pt & 3) * 8);
}
__device__ __forceinline__ void gla_pin(GlaIn& I) {
#pragma unroll
    for (int r = 0; r < 2; ++r) {
#pragma unroll
        for (int k = 0; k < 4; ++k) asm volatile("" : "+v"(I.b[r][k]));
#pragma unroll
        for (int i = 0; i < 2; ++i) { asm volatile("" : "+v"(I.q[r][i])); asm volatile("" : "+v"(I.k[r][i])); }
    }
    asm volatile("" : "+v"(I.v));
}
__device__ __forceinline__ void gla_prep(const GlaIn& I, LAS unsigned char* lds, int buf, int pt) {
    const int prow = pt >> 3, pdc = pt & 7;
#pragma unroll
    for (int r = 0; r < 2; ++r)
#pragma unroll
        for (int i = 0; i < 2; ++i) {
            float qf[8], kf[8]; un8(I.q[r][i], qf); un8(I.k[r][i], kf);
            float x[8], y[8];
#pragma unroll
            for (int j = 0; j < 8; ++j) { const float bb = I.b[r][2 * i + (j >> 2)][j & 3];
                const float e1 = __builtin_amdgcn_exp2f(bb), e2 = __builtin_amdgcn_rcpf(e1);
                x[j] = qf[j] * e1; y[j] = kf[j] * e2; }
            LAS unsigned char* wp = lds + buf * G2_QB + (prow + 32 * r) * G2_QP + (8 * pdc + 64 * i) * 2;
            v4u w;
            w.x = cvt_pk_bf16(x[0], x[1]); w.y = cvt_pk_bf16(x[2], x[3]); w.z = cvt_pk_bf16(x[4], x[5]); w.w = cvt_pk_bf16(x[6], x[7]); *(LAS v4u*)(wp + G2_QD) = w;
            w.x = cvt_pk_bf16(y[0], y[1]); w.y = cvt_pk_bf16(y[2], y[3]); w.z = cvt_pk_bf16(y[4], y[5]); w.w = cvt_pk_bf16(y[6], y[7]); *(LAS v4u*)(wp + G2_KI) = w;
        }
    if (prow == 31) {
#pragma unroll
        for (int i = 0; i < 2; ++i) { *(LAS f32x4*)(lds + G2_BL + buf * 512 + (8 * pdc + 64 * i) * 4) = I.b[1][2 * i]; *(LAS f32x4*)(lds + G2_BL + buf * 512 + (8 * pdc + 64 * i + 4) * 4) = I.b[1][2 * i + 1]; }
    }
    *(LAS v4u*)(lds + G2_V + buf * G2_VB + (pt >> 2) * G2_VP + (pt & 3) * 16) = I.v;
}
__device__ __forceinline__ void glds16_asm(const void* gsrc, unsigned lds_dst) {
    unsigned keep;
    asm volatile("s_mov_b32 %0, m0\n\ts_mov_b32 m0, %2\n\ts_nop 0\n\tglobal_load_lds_dwordx4 %1, off\n\ts_mov_b32 m0, %0" : "=&s"(keep) : "v"(gsrc), "s"(lds_dst) : "memory");
}
__device__ __forceinline__ void side_dma(const TItem& t, int lane, LAS float* scr, LAS float* gscr, const float* ones) {
    const float* p = t.src + (size_t)(lane >> 3) * t.ldw + 4 * (lane & 7);
    const unsigned dst = __builtin_amdgcn_readfirstlane((unsigned)(unsigned long long)scr), gdst = __builtin_amdgcn_readfirstlane((unsigned)(unsigned long long)gscr);
#pragma unroll
    for (int i = 0; i < 8; ++i) glds16_asm(p + (size_t)(8 * i) * t.ldw, dst + i * 1024);
    glds16_asm((t.gk ? t.gk : ones) + 4 * (lane & 15), gdst);
}
__device__ __forceinline__ void side_store(const TItem& t, int lane, LAS float* scr, const LAS float* gscr) {
    const int c = lane & 7;
    const f32x4 g0 = *(const LAS f32x4*)(gscr + 8 * c), g1 = *(const LAS f32x4*)(gscr + 8 * c + 4);
#pragma unroll
    for (int j = 0; j < 4; ++j) { const int n = (lane >> 3) + 8 * j; const LAS float* q = scr + (8 * c) * 32 + n;
        v4u o; o.x = cvt_pk_bf16(q[0 * 32] * g0[0], q[1 * 32] * g0[1]); o.y = cvt_pk_bf16(q[2 * 32] * g0[2], q[3 * 32] * g0[3]); o.z = cvt_pk_bf16(q[4 * 32] * g1[0], q[5 * 32] * g1[1]); o.w = cvt_pk_bf16(q[6 * 32] * g1[2], q[7 * 32] * g1[3]);
        *(GAS v4u*)(t.dst + (size_t)n * t.ldt + 8 * c) = o; }
    LDS_WAIT(); asm volatile("" ::: "memory");
}
constexpr int SIDE_GS = 141312;
static_assert(G2_ST1 + 32 * G2_SP <= SIDE_GS && SIDE_GS + 4096 <= LDS_BYTES, "GLA LDS map");
constexpr int SIDE_SCR = G2_KE;
static_assert(SIDE_SCR + 4 * 8192 <= G2_V, "GLA LDS map");
__device__ __forceinline__ void gla_phase(const bf16* Z, const float* LA, float* OS, LAS unsigned char* lds, int tid, int G, const SideJob& J, unsigned char* ws) {
    const int lane = tid & 63, wave = __builtin_amdgcn_readfirstlane(tid >> 6), r32 = lane & 31, hh = lane >> 5;
    const int tq = (lane & 15) >> 2, tp = lane & 3, tcb = 16 * ((lane >> 4) & 1);
    const f32x16 zero16 = {0.f, 0.f, 0.f, 0.f, 0.f, 0.f, 0.f, 0.f, 0.f, 0.f, 0.f, 0.f, 0.f, 0.f, 0.f, 0.f};
    const int nmain = J.l == 0 ? NS_ITEMS + I_IN : NS_ITEMS;
    bool side_first = true;
    for (int it = blockIdx.x; it < 256; it += G) {
        const int b = it & 7, h = (it >> 3) & 3, es = it >> 5;
        const size_t R00 = (size_t)b * SEQ;
        for (int i = tid; i < 32 * G2_SP / 16; i += NWAVES * 64) *(LAS v4u*)(lds + G2_ST0 + i * 16) = (v4u){0u, 0u, 0u, 0u};
        if (wave >= 4) {
            const int pt = tid - 256;
            GlaIn IA, IB;
            __builtin_amdgcn_s_waitcnt(0x0F70);
            gla_load(IA, Z, LA, R00, h, es, pt);
            gla_prep(IA, lds, 0, pt);
            gla_load(IA, Z, LA, R00 + 64, h, es, pt);
            asm volatile("" ::: "memory");
            gla_load(IB, Z, LA, R00 + 128, h, es, pt);
            GLA_BAR();
            for (int t = 0; t < 32; t += 2) {
                gla_pin(IA); gla_prep(IA, lds, 1, pt);
                gla_load(IA, Z, LA, R00 + 64 * (t + 3 < 32 ? t + 3 : 31), h, es, pt);
                GLA_BAR();
                gla_pin(IB); gla_prep(IB, lds, 0, pt);
                gla_load(IB, Z, LA, R00 + 64 * (t + 4 < 32 ? t + 4 : 31), h, es, pt);
                GLA_BAR();
            }
        } else {
            f32x16 S0 = zero16, S1 = zero16;
            const bool side_on = side_first && wave >= 2;
            LAS float* sscr = (LAS float*)(lds + SIDE_SCR + (wave >= 2 ? wave - 2 : 0) * 16384);
            LAS float* sgs = (LAS float*)(lds + SIDE_GS + (wave >= 2 ? wave - 2 : 0) * 2048);
            const float* ones = (const float*)(ws + WS_ONES);
            if (side_on) {
#pragma unroll
                for (int j = 0; j < 2; ++j) { const int gi = (2 * j + (wave - 2)) * G + (int)blockIdx.x; if (gi < nmain) { const TItem d = decode_job(J, ws, gi); side_dma(d, lane, sscr + j * 2048, sgs + j * 256, ones); } }
            }
            GLA_BAR();
            for (int t = 0; t < 32; ++t) {
                const int buf = t & 1;
                if (wave < 2) {
                    const int lt = wave;
                    const LAS unsigned char* qdp = lds + G2_QD + buf * G2_QB + (32 * lt + r32) * G2_QP + 16 * hh;
                    const LAS unsigned char* stp = lds + (buf ? G2_ST1 : G2_ST0) + r32 * G2_SP + 16 * hh;
                    const LAS unsigned char* kip = lds + G2_KI + buf * G2_QB + r32 * G2_QP + 16 * hh;
                    bf16x8 qf[8], fr[8];
#pragma unroll
                    for (int ks = 0; ks < 8; ++ks) { qf[ks] = *(const LAS bf16x8*)(qdp + 32 * ks); fr[ks] = *(const LAS bf16x8*)(kip + 32 * ks); }
                    f32x16 a = zero16, o = zero16;
#pragma unroll
                    for (int ks = 0; ks < 8; ++ks) a = __builtin_amdgcn_mfma_f32_32x32x16_bf16(fr[ks], qf[ks], a, 0, 0, 0);
#pragma unroll
                    for (int ks = 0; ks < 8; ++ks) fr[ks] = *(const LAS bf16x8*)(stp + 32 * ks);
#pragma unroll
                    for (int ks = 0; ks < 8; ++ks) o = __builtin_amdgcn_mfma_f32_32x32x16_bf16(fr[ks], qf[ks], o, 0, 0, 0);
                    if (lt == 1) {
#pragma unroll
                        for (int ks = 0; ks < 8; ++ks) fr[ks] = *(const LAS bf16x8*)(kip + 32 * G2_QP + 32 * ks);
                    }
                    const LAS unsigned char* vp = lds + G2_V + buf * G2_VB + (4 * hh + tq) * G2_VP + (tcb + 4 * tp) * 2;
                    if (lt == 0) {
#pragma unroll
                        for (int rho = 0; rho < 16; ++rho) { const int sr = (rho & 3) + 8 * (rho >> 2) + 4 * hh; a[rho] = r32 >= sr ? a[rho] : 0.f; }
                    }
#pragma unroll
                    for (int s2 = 0; s2 < 2; ++s2) {
                        v4u pw; pw.x = cvt_pk_bf16(a[8 * s2 + 0], a[8 * s2 + 1]); pw.y = cvt_pk_bf16(a[8 * s2 + 2], a[8 * s2 + 3]); pw.z = cvt_pk_bf16(a[8 * s2 + 4], a[8 * s2 + 5]); pw.w = cvt_pk_bf16(a[8 * s2 + 6], a[8 * s2 + 7]);
                        const bf16x8 vf = mk8(lds_tr(vp + 16 * s2 * G2_VP), lds_tr(vp + (16 * s2 + 8) * G2_VP));
                        o = __builtin_amdgcn_mfma_f32_32x32x16_bf16(vf, __builtin_bit_cast(bf16x8, pw), o, 0, 0, 0);
                    }
                    if (lt == 1) {
                        a = zero16;
#pragma unroll
                        for (int ks = 0; ks < 8; ++ks) a = __builtin_amdgcn_mfma_f32_32x32x16_bf16(fr[ks], qf[ks], a, 0, 0, 0);
#pragma unroll
                        for (int rho = 0; rho < 16; ++rho) { const int sr = (rho & 3) + 8 * (rho >> 2) + 4 * hh; a[rho] = r32 >= sr ? a[rho] : 0.f; }
#pragma unroll
                        for (int s2 = 0; s2 < 2; ++s2) {
                            v4u pw; pw.x = cvt_pk_bf16(a[8 * s2 + 0], a[8 * s2 + 1]); pw.y = cvt_pk_bf16(a[8 * s2 + 2], a[8 * s2 + 3]); pw.z = cvt_pk_bf16(a[8 * s2 + 4], a[8 * s2 + 5]); pw.w = cvt_pk_bf16(a[8 * s2 + 6], a[8 * s2 + 7]);
                            const bf16x8 vf = mk8(lds_tr(vp + (32 + 16 * s2) * G2_VP), lds_tr(vp + (32 + 16 * s2 + 8) * G2_VP));
                            o = __builtin_amdgcn_mfma_f32_32x32x16_bf16(vf, __builtin_bit_cast(bf16x8, pw), o, 0, 0, 0);
                        }
                    }
                    bf16* op = (bf16*)OS + (R00 + 64 * t + 32 * wave + r32) * 1024 + h * 256 + es * 32 + 4 * hh;
#pragma unroll
                    for (int g = 0; g < 4; ++g) { v2u w; w.x = cvt_pk_bf16(o[4 * g], o[4 * g + 1]); w.y = cvt_pk_bf16(o[4 * g + 2], o[4 * g + 3]); *(GAS v2u*)(op + 8 * g) = w; }
                } else {
                    LAS unsigned char* stn = lds + (buf ? G2_ST0 : G2_ST1);
                    const LAS unsigned char* vp = lds + G2_V + buf * G2_VB + (8 * hh + tq) * G2_VP + (tcb + 4 * tp) * 2;
                    const LAS unsigned char* kp = lds + G2_KI + buf * G2_QB + (8 * hh + tq) * G2_QP + (64 * (wave - 2) + tcb + 4 * tp) * 2;
                    bf16x8 vf8[4], k0[4], k1[4];
#pragma unroll
                    for (int ks = 0; ks < 4; ++ks) { vf8[ks] = mk8(lds_tr(vp + 16 * ks * G2_VP), lds_tr(vp + (16 * ks + 4) * G2_VP));
                        k0[ks] = mk8(lds_tr(kp + 16 * ks * G2_QP), lds_tr(kp + (16 * ks + 4) * G2_QP)); k1[ks] = mk8(lds_tr(kp + 64 + 16 * ks * G2_QP), lds_tr(kp + 64 + (16 * ks + 4) * G2_QP)); }
#pragma unroll
                    for (int ks = 0; ks < 4; ++ks) { S0 = __builtin_amdgcn_mfma_f32_32x32x16_bf16(k0[ks], vf8[ks], S0, 0, 0, 0); S1 = __builtin_amdgcn_mfma_f32_32x32x16_bf16(k1[ks], vf8[ks], S1, 0, 0, 0); }
#pragma unroll
                    for (int rho = 0; rho < 16; ++rho) { const LAS float* bp = (const LAS float*)(lds + G2_BL + buf * 512) + 64 * (wave - 2) + (rho & 3) + 8 * (rho >> 2) + 4 * hh; S0[rho] *= __builtin_amdgcn_exp2f(bp[0]); S1[rho] *= __builtin_amdgcn_exp2f(bp[32]); }
#pragma unroll
                    for (int g = 0; g < 4; ++g) {
                        v2u w; w.x = cvt_pk_bf16(S0[4 * g], S0[4 * g + 1]); w.y = cvt_pk_bf16(S0[4 * g + 2], S0[4 * g + 3]); *(LAS v2u*)(stn + r32 * G2_SP + (64 * (wave - 2) + 8 * g + 4 * hh) * 2) = w;
                        w.x = cvt_pk_bf16(S1[4 * g], S1[4 * g + 1]); w.y = cvt_pk_bf16(S1[4 * g + 2], S1[4 * g + 3]); *(LAS v2u*)(stn + r32 * G2_SP + (64 * (wave - 2) + 32 + 8 * g + 4 * hh) * 2) = w;
                    }
                    if (side_on) {
                        { const int gnx = (2 * (t + 1) + (wave - 2)) * G + (int)blockIdx.x;
                          if (t + 1 < 32 && gnx < nmain) { if (t == 0) asm volatile("s_waitcnt vmcnt(9)" ::: "memory"); else asm volatile("s_waitcnt vmcnt(13)" ::: "memory"); } else asm volatile("s_waitcnt vmcnt(0)" ::: "memory"); }
                        LAS float* sb = sscr + buf * 2048; LAS float* gb = sgs + buf * 256;
                        int ls = lane; asm volatile("" : "+v"(ls));
                        const int gi = (2 * t + (wave - 2)) * G + (int)blockIdx.x;
                        if (gi < nmain) { const TItem d = decode_job(J, ws, gi); side_store(d, ls, sb, gb); }
                        const int gn = (2 * (t + 2) + (wave - 2)) * G + (int)blockIdx.x;
                        if (t + 2 < 32 && gn < nmain) { const TItem d = decode_job(J, ws, gn); side_dma(d, ls, sb, gb, ones); }
                    }
                }
                GLA_BAR();
            }
        }
        __syncthreads();
        side_first = false;
    }
    {
        float sv[32]; f32x4 sg[2];
        LAS float* scr = (LAS float*)(lds + RING_OFF + wave * 16384);
        for (int q = 64 + wave; ; q += NWAVES) { const int gi = q * G + (int)blockIdx.x; if (gi >= nmain) break; const TItem d = decode_job(J, ws, gi); titem_load(d, lane, sv, sg); titem_store(d, lane, sv, sg, scr); }
        if (J.l == 0) for (int r = (int)blockIdx.x * NWAVES + wave; r < I_AL; r += G * NWAVES) { const int kb = r / 16, jb = r % 16; alpha_item((const float*)J.ap->in[3] + (size_t)DM * WIN_LD, (const float*)J.ap->in[5] + 16 * 512, (const float*)J.ap->in[2] + DM, kb * 64, jb * 32, (bf16*)(ws + WS_WIN), scr, lane); }
    }
}
__device__ __forceinline__ void yb_norm(const float* OS, const bf16* Z, const float* gg, bf16* Y, int gw, int NGW, int lane) {
    const f32x4 g = *(const GAS f32x4*)(gg + 4 * lane);
    for (int item0 = gw * 4; item0 < M * 4; item0 += NGW * 4) {
        f32x4 o[4]; v2u r[4]; float ss[4];
#pragma unroll
        for (int k = 0; k < 4; ++k) { const int item = item0 + k, row = item >> 2, h = item & 3;
            { const v2u ow = *(const GAS v2u*)((const bf16*)OS + (size_t)row * 1024 + h * 256 + 4 * lane); o[k] = (f32x4){bflo(ow.x), bfhi(ow.x), bflo(ow.y), bfhi(ow.y)}; } r[k] = *(const GAS v2u*)(Z + (size_t)row * NZ + ZRB + h * 256 + 4 * lane);
            ss[k] = (o[k].x * o[k].x + o[k].y * o[k].y) + (o[k].z * o[k].z + o[k].w * o[k].w); }
#pragma unroll
        for (int off = 1; off < 64; off <<= 1) {
#pragma unroll
            for (int k = 0; k < 4; ++k) ss[k] += __shfl_xor(ss[k], off); }
#pragma unroll
        for (int k = 0; k < 4; ++k) { const int item = item0 + k, row = item >> 2, h = item & 3;
            const float rs = 1.0f / sqrtf(ss[k] * (1.0f / 256.0f) + pg8::RMS_EPS);
            v2u w; w.x = cvt_pk_bf16(o[k].x * rs * g.x * bflo(r[k].x), o[k].y * rs * g.y * bfhi(r[k].x)); w.y = cvt_pk_bf16(o[k].z * rs * g.z * bflo(r[k].y), o[k].w * rs * g.w * bfhi(r[k].y));
            *(GAS v2u*)(Y + (size_t)row * DM + 1024 + h * 256 + 4 * lane) = w; }
    }
}
__device__ __forceinline__ void conv_fixup(const bf16* HF, const bf16* HL, const float* cw, const float* cb, bf16* ACT, int pm, int tid) {
    for (int cg = tid; cg < 704; cg += NWAVES * 64) {
        const int c0 = cg * 8, pn = c0 >> 7, j0 = c0 & 127, hcol = 256 * pn + j0;
        const bool first = (pm & 7) == 0;
        float h[4][2][8];
#pragma unroll
        for (int k = 0; k < 2; ++k)
#pragma unroll
            for (int gu = 0; gu < 2; ++gu) {
                v4u a = {0u, 0u, 0u, 0u};
                if (!first) a = *(const GAS v4u*)(HL + (size_t)((pm - 1) * 2 + k) * NH + hcol + 128 * gu);
                const v4u b = *(const GAS v4u*)(HF + (size_t)(pm * 2 + k) * NH + hcol + 128 * gu);
                un8h(a, h[k][gu]); un8h(b, h[2 + k][gu]);
            }
#pragma unroll
        for (int k = 0; k < 2; ++k) {
            float a[8];
#pragma unroll
            for (int i = 0; i < 8; ++i) {
                const int c = c0 + i;
                const float gc = cb[c] + cw[c] * h[k][0][i] + cw[NH + c] * h[k + 1][0][i] + cw[2 * NH + c] * h[k + 2][0][i];
                const float uc = cb[DFF + c] + cw[DFF + c] * h[k][1][i] + cw[NH + DFF + c] * h[k + 1][1][i] + cw[2 * NH + DFF + c] * h[k + 2][1][i];
                a[i] = gc * pg8::sigmoidf_fast(gc) * uc;
            }
            v4u w; w.x = cvt_pk_bf16(a[0], a[1]); w.y = cvt_pk_bf16(a[2], a[3]); w.z = cvt_pk_bf16(a[4], a[5]); w.w = cvt_pk_bf16(a[6], a[7]);
            *(GAS v4u*)(ACT + (size_t)(pm * 256 + k) * DFF + c0) = w;
        }
    }
}
__device__ __forceinline__ void final_norm(const bf16* xb, float* out, const float* fg, int gw, int NGW, int lane) {
    for (int m0 = gw * 2; m0 < M; m0 += NGW * 2) {
        v4u v[2][4]; float s[2] = {0.f, 0.f};
#pragma unroll
        for (int k = 0; k < 2; ++k) { const GAS v4u* xr = (const GAS v4u*)(xb + (size_t)(m0 + k) * DM) + lane;
#pragma unroll
            for (int j = 0; j < 4; ++j) { v[k][j] = xr[64 * j]; float f[8]; un8(v[k][j], f);
#pragma unroll
                for (int i = 0; i < 8; ++i) s[k] += f[i] * f[i]; } }
#pragma unroll
        for (int off = 1; off < 64; off <<= 1) { s[0] += __shfl_xor(s[0], off); s[1] += __shfl_xor(s[1], off); }
#pragma unroll
        for (int k = 0; k < 2; ++k) { const float rs = 1.0f / sqrtf(s[k] * (1.0f / DM) + pg8::RMS_EPS);
#pragma unroll
            for (int j = 0; j < 4; ++j) { float f[8]; un8(v[k][j], f); const GAS f32x4* gr = (const GAS f32x4*)(fg + 8 * lane + 512 * j); GAS f32x4* orow = (GAS f32x4*)(out + (size_t)(m0 + k) * DM + 8 * lane + 512 * j);
                const f32x4 g0 = gr[0], g1 = gr[1];
                orow[0] = (f32x4){f[0] * rs * g0[0], f[1] * rs * g0[1], f[2] * rs * g0[2], f[3] * rs * g0[3]}; orow[1] = (f32x4){f[4] * rs * g1[0], f[5] * rs * g1[1], f[6] * rs * g1[2], f[7] * rs * g1[3]}; } }
    }
}
__global__ void __launch_bounds__(NWAVES * 64, 2) fwd(Args args) {
    extern __shared__ __attribute__((aligned(16))) unsigned char lds_raw[];
    LAS unsigned char* lds = (LAS unsigned char*)lds_raw;
    volatile LAS unsigned* MISC = (volatile LAS unsigned*)(lds + MISC_OFF);
    const int wave_s = __builtin_amdgcn_readfirstlane((int)threadIdx.x >> 6);
    const int G = gridDim.x, NGW = G * NWAVES, NT = G * NWAVES * 64;
    {
        const int tid = threadIdx.x;
        for (int u = tid; u < (LDS_BYTES - LDSCTL_OFF) / 4 && u < 256; u += NWAVES * 64) ((LAS unsigned*)(lds + LDSCTL_OFF))[u] = 0u;
    }
    __syncthreads();
    XcdBarrier bar = xcd_barrier_post((unsigned*)((gu32*)(args.ws + WS_CTL) + CW_BAR), MISC + 8);
    const int lo = args.ph_lo, hi = args.ph_hi;
#define IN(p) (lo <= (p) && (p) < hi)
#define SEAM(p) do { if (IN(p) && IN((p) + 1)) { XcdBarrier b2 = bar; asm volatile("" : "+s"(b2.x)); xcd_barrier(b2); } } while (0)

    for (int l = 0; l < 2; ++l) {
        const int pb = 9 * l;
#define INP(k) ((const float*)ap->in[k])
#define PHASE_IDS() const __attribute__((address_space(4))) Args* ap = (const __attribute__((address_space(4))) Args*)__builtin_amdgcn_kernarg_segment_ptr(); asm volatile("" : "+s"(ap)); unsigned char* const ws = ap->ws; (void)ws; unsigned ones_ = ~0u; asm volatile("" : "+s"(ones_)); int tidp = wave_s * 64 + (int)__builtin_amdgcn_mbcnt_hi(ones_, __builtin_amdgcn_mbcnt_lo(ones_, 0u)); asm volatile("" : "+v"(tidp)); const int lanep = tidp & 63, wavep = __builtin_amdgcn_readfirstlane(tidp >> 6), gwp = blockIdx.x * NWAVES + wavep, gtp = blockIdx.x * (NWAVES * 64) + tidp; (void)lanep; (void)gwp; (void)gtp
        if (IN(pb + 0) && l == 0) { PHASE_IDS();
            LayerIn L;
            L.gmix = INP(2); L.win = INP(3); L.wau = INP(5);
            phase_weights(L, ws, lds, gwp, NGW, wavep, lanep);
            phase_xprep(INP(0), (const int*)ap->in[1], ws, gwp, NGW, lanep);
        }
        if (l == 0) SEAM(pb + 0);
        if (IN(pb + 1)) { PHASE_IDS();
            pg8::Gemm g{(bf16*)(ws + WS_XB), (bf16*)(ws + WS_WIN), M, NZ, DM, DM, nullptr, nullptr}; pg8::StaticOrder S; S.init(M, NZ, G, (int)blockIdx.x);
            fill_rstd_table((float*)(ws + WS_SSQ), lds, tidp);
            pg8::EpiZ E{(bf16*)(ws + WS_ZB), (float*)(ws + WS_LA), (const LAS float*)(lds + RSTAB_OFF), (float*)(ws + WS_ROPE), INP(6) + l * 512};
            pg8::gemm_phase<pg8::EpiZ, pg8::StaticOrder, true, true>(lds + RING_OFF, g, S, E, tidp);
        }
        SEAM(pb + 1);
        if (IN(pb + 2)) { PHASE_IDS(); swa_phase((bf16*)(ws + WS_ZB), INP(4) + l * 16, (bf16*)(ws + WS_Y), lds, tidp, G); int tid2 = tidp; asm volatile("" : "+v"(tid2)); SideJob J; J.ap = ap; J.l = l; gla_phase((bf16*)(ws + WS_ZB), (float*)(ws + WS_LA), ap->out, lds, tid2, G, J, ws); }
        SEAM(pb + 2);
        if (IN(pb + 3)) { PHASE_IDS(); yb_norm(ap->out, (bf16*)(ws + WS_ZB), INP(7) + l * 256, (bf16*)(ws + WS_Y), gwp, NGW, lanep); }
        SEAM(pb + 3);
        if (IN(pb + 4)) { PHASE_IDS();
            pg8::Gemm g{(bf16*)(ws + WS_Y), (bf16*)(ws + WS_WA), M, DM, 1024, DM, (bf16*)(ws + WS_Y) + 1024, (bf16*)(ws + WS_WB)}; pg8::TwoSegOrder S; S.init(M, DM, G, (int)blockIdx.x);
            pg8::EpiMix E{(bf16*)(ws + WS_MIX), (bf16*)(ws + WS_ZB) + ZGA, (bf16*)(ws + WS_ZB) + ZGB};
            pg8::gemm_phase<pg8::EpiMix, pg8::TwoSegOrder, true, true>(lds + RING_OFF, g, S, E, tidp);
        }
        SEAM(pb + 4);
        if (IN(pb + 5)) { PHASE_IDS();
            pg8::Gemm g{(bf16*)(ws + WS_MIX), (bf16*)(ws + WS_WO), M, DM, DM, DM, nullptr, nullptr}; pg8::StaticOrder S; S.init(M, DM, G, (int)blockIdx.x);
            pg8::EpiRes E{(bf16*)(ws + WS_XB), (float*)(ws + WS_SSQ)};
            pg8::gemm_phase<pg8::EpiRes, pg8::StaticOrder, true, true>(lds + RING_OFF, g, S, E, tidp);
        }
        SEAM(pb + 5);
        if (IN(pb + 6)) { PHASE_IDS();
            pg8::Gemm g{(bf16*)(ws + WS_XB), (bf16*)(ws + WS_WUP), M, NH, DM, DM, nullptr, nullptr}; pg8::StaticOrder S; S.init(M, NH, G, (int)blockIdx.x);
            fill_rstd_table((float*)(ws + WS_SSQ), lds, tidp);
            pg8::EpiUp E{(bf16*)(ws + WS_ACT), (const LAS float*)(lds + RSTAB_OFF), (LAS unsigned*)(lds + XL_OFF), (LAS unsigned*)(lds + CWL_OFF), INP(13) + (size_t)l * 3 * NH, INP(14) + (size_t)l * NH, (bf16*)(ws + WS_HF), (bf16*)(ws + WS_HL)};
            pg8::gemm_phase<pg8::EpiUp, pg8::StaticOrder, true, true>(lds + RING_OFF, g, S, E, tidp);
        }
        SEAM(pb + 6);
        if (IN(pb + 8)) { PHASE_IDS();
            pg8::Gemm g{(bf16*)(ws + WS_ACT), (bf16*)(ws + WS_WDN), M, DM, DFF, DFF, nullptr, nullptr}; pg8::StaticOrder S; S.init(M, DM, G, (int)blockIdx.x);
            {
                pg8::Unit uu; int prev = -1;
                for (int i = 0; S.next(i, uu); ++i) if (uu.pm != prev) { prev = uu.pm; conv_fixup((bf16*)(ws + WS_HF), (bf16*)(ws + WS_HL), INP(13) + (size_t)l * 3 * NH, INP(14) + (size_t)l * NH, (bf16*)(ws + WS_ACT), uu.pm, tidp); }
                asm volatile("s_waitcnt vmcnt(0)" ::: "memory"); __syncthreads();
            }
            pg8::EpiRes E{(bf16*)(ws + WS_XB), (float*)(ws + WS_SSQ)};
            pg8::gemm_phase<pg8::EpiRes, pg8::StaticOrder, true, true>(lds + RING_OFF, g, S, E, tidp);
        }
        SEAM(pb + 8);
    }
    if (IN(18)) { PHASE_IDS(); final_norm((const bf16*)(ws + WS_XB), ap->out, (const float*)ap->in[16], gwp, NGW, lanep); }
#undef IN
#undef SEAM
}

#ifndef N_LAUNCH_MODE
#define N_LAUNCH_MODE 1
#endif
extern "C" void kernel_launch(void* const* d_in, const int* in_sizes, int n_in, void* d_out, int out_size, void* d_ws, size_t ws_size, hipStream_t stream) {
    static int grid = 0;
    if (grid == 0) {
        if (n_in != 17 || out_size != M * DM || ws_size < WS_END) { fprintf(stderr, "kernel_launch: unexpected shapes (n_in %d out %d ws %zu)\n", n_in, out_size, ws_size); grid = -1; return; }
        int dev = 0, cus = 0, per_cu = 0;
        if (hipGetDevice(&dev) != hipSuccess || hipDeviceGetAttribute(&cus, hipDeviceAttributeMultiprocessorCount, dev) != hipSuccess) { grid = -1; return; }
        if (hipFuncSetAttribute((const void*)fwd, hipFuncAttributeMaxDynamicSharedMemorySize, LDS_BYTES) != hipSuccess) { fprintf(stderr, "kernel_launch: hipFuncSetAttribute failed\n"); grid = -1; return; }
        if (hipOccupancyMaxActiveBlocksPerMultiprocessor(&per_cu, (const void*)fwd, NWAVES * 64, LDS_BYTES) != hipSuccess || per_cu < 1) fprintf(stderr, "kernel_launch: occupancy query reports %d\n", per_cu);
        (void)hipGetLastError();
        grid = cus;
        if (grid % 8 != 0) { fprintf(stderr, "kernel_launch: CU count %d is not a multiple of 8 (the per-CU row-statistics table assumes it)\n", grid); grid = -1; return; }
    }
    if (grid < 0) return;
    if (hipMemsetAsync((char*)d_ws + WS_CTL, 0, CTL_ZERO_BYTES, stream) != hipSuccess) return;
    Args a{};
    for (int i = 0; i < 17; ++i) a.in[i] = d_in[i];
    a.out = (float*)d_out; a.ws = (unsigned char*)d_ws;
    if (N_LAUNCH_MODE == 1) { a.ph_lo = 0; a.ph_hi = N_PHASES; hipLaunchKernelGGL(fwd, dim3(grid), dim3(NWAVES * 64), LDS_BYTES, stream, a); }
    else for (int p = 0; p < N_PHASES; ++p) { a.ph_lo = p; a.ph_hi = p + 1; hipLaunchKernelGGL(fwd, dim3(grid), dim3(NWAVES * 64), LDS_BYTES, stream, a); }
}
```
